# Optimizing an MI355X kernel written in HIP

```python
import math
import jax, jax.numpy as jnp
from jax import lax
import numpy as np

D_MODEL = 2048
BATCH = 4
SEQ = 4096
DEPTH = 4
DEC_BATCH = 8
DEC_SEQ = 32
PAST_LEN = 1024

CHUNK = 64
QBLOCK = 128
N_MIXERS = 3
D_INNER = D_MODEL
NORM_EPS = 1e-6
GLA_HEADS = 4
GLA_KD = D_INNER // 2
GLA_DK = GLA_KD // GLA_HEADS
GLA_DV = D_INNER // GLA_HEADS
GLA_GATE_RANK = 16
GLA_GATE_NORMALIZER = 16.0
HGRN_EXPAND = 128
HGRN_HEADS = D_INNER // HGRN_EXPAND
HGRN_DK = HGRN_EXPAND
HGRN_DV = D_INNER // HGRN_HEADS
DIFF_HD = 128
DIFF_HEADS = D_INNER // (2 * DIFF_HD)
N_GLA = (DEPTH + 2) // 3
N_HGRN = (DEPTH + 1) // 3
N_DIFF = DEPTH // 3

kernel_name = 'hybrid_gla_hgrn2_diffattn_stream_step'


def _rmsnorm(x, w):
    xf = x.astype(jnp.float32)
    y = xf * lax.rsqrt(jnp.mean(xf * xf, axis=-1, keepdims=True) + NORM_EPS)
    return (y * w.astype(jnp.float32)).astype(x.dtype)


def _gated_linear_chunk(S, q, k, v, g):
    c = q.shape[2]
    b = jnp.cumsum(g, axis=2)
    o_inter = jnp.einsum('bhck,bhkv->bhcv', q * jnp.exp(b), S)
    causal = jnp.tril(jnp.ones((c, c), dtype=bool))[:, :, None]
    rel = jnp.where(causal, b[:, :, :, None, :] - b[:, :, None, :, :], -jnp.inf)
    attn = jnp.einsum('bhtk,bhsk,bhtsk->bhts', q, k, jnp.exp(rel))
    o_intra = jnp.einsum('bhts,bhsv->bhtv', attn, v)
    b_last = b[:, :, -1, :]
    k_dec = k * jnp.exp(b_last[:, :, None, :] - b)
    S_new = jnp.exp(b_last)[..., None] * S + jnp.einsum('bhck,bhcv->bhkv', k_dec, v)
    return S_new, o_inter + o_intra


def _gated_linear_recurrence(q, k, v, g, S0):
    B, T, H, _ = q.shape
    c = min(CHUNK, T)
    n = T // c

    def to_chunks(a):
        return a.astype(jnp.float32).reshape(B, n, c, H, a.shape[-1]).transpose(1, 0, 3, 2, 4)

    S, o = lax.scan(lambda s, inp: _gated_linear_chunk(s, *inp), S0.astype(jnp.float32),
                    (to_chunks(q), to_chunks(k), to_chunks(v), to_chunks(g)))
    o = o.transpose(1, 0, 3, 2, 4).reshape(B, T, H, v.shape[-1])
    return o, S


def _gla_branch(h, S0, w_in, w_a1, w_a2, b_a, norm_w, w_out):
    B, T, _ = h.shape
    q, k, v, z = jnp.split(h @ w_in, [GLA_KD, 2 * GLA_KD, 2 * GLA_KD + D_INNER], axis=-1)
    glog = jax.nn.log_sigmoid(((h @ w_a1) @ w_a2 + b_a).astype(jnp.float32)) / GLA_GATE_NORMALIZER
    q = q.reshape(B, T, GLA_HEADS, GLA_DK) * (GLA_DK ** -0.5)
    k = k.reshape(B, T, GLA_HEADS, GLA_DK)
    v = v.reshape(B, T, GLA_HEADS, GLA_DV)
    glog = glog.reshape(B, T, GLA_HEADS, GLA_DK)
    o, S = _gated_linear_recurrence(q, k, v, glog, S0)
    o = _rmsnorm(o, norm_w).reshape(B, T, D_INNER).astype(h.dtype)
    return (o * jax.nn.silu(z)) @ w_out, S


def _hgrn2_branch(h, S0, lower_bound, w_in, norm_w, w_out):
    B, T, _ = h.shape
    q, f, i, z = jnp.split(h @ w_in, 4, axis=-1)
    q = jax.nn.silu(q)
    fgate = lower_bound + (1.0 - lower_bound) * jax.nn.sigmoid(f.astype(jnp.float32))
    k = 1.0 - fgate
    g = jnp.log(fgate)
    q = q.reshape(B, T, HGRN_HEADS, HGRN_DK) * (HGRN_DK ** -0.5)
    k = k.reshape(B, T, HGRN_HEADS, HGRN_DK)
    g = g.reshape(B, T, HGRN_HEADS, HGRN_DK)
    i = i.reshape(B, T, HGRN_HEADS, HGRN_DV)
    o, S = _gated_linear_recurrence(q, k, i, g, S0)
    o = _rmsnorm(o.reshape(B, T, D_INNER), norm_w).astype(h.dtype)
    return (o * jax.nn.silu(z)) @ w_out, S


def _diff_project(h, w_in):
    B, T, _ = h.shape
    q, k, v, z = jnp.split(h @ w_in, 4, axis=-1)
    q = q.reshape(B, T, 2 * DIFF_HEADS, DIFF_HD)
    k = k.reshape(B, T, 2 * DIFF_HEADS, DIFF_HD)
    v = v.reshape(B, T, DIFF_HEADS, 2 * DIFF_HD)
    return q, k, v, z


def _diff_lambda(lam_p, lam_init):
    lp = lam_p.astype(jnp.float32)
    return jnp.exp(jnp.sum(lp[0] * lp[1])) - jnp.exp(jnp.sum(lp[2] * lp[3])) + lam_init


def _diff_attend(q, k, v, lam, mask):
    B, Tq = q.shape[:2]
    Tk = k.shape[1]
    s = jnp.einsum('bqnd,bknd->bnqk', q, k, preferred_element_type=jnp.float32) * (DIFF_HD ** -0.5)
    if mask is not None:
        s = jnp.where(mask, s, -jnp.inf)
    p = jax.nn.softmax(s, axis=-1).reshape(B, DIFF_HEADS, 2, Tq, Tk)
    a = p[:, :, 0] - lam * p[:, :, 1]
    return jnp.einsum('bhqk,bkhe->bqhe', a, v.astype(jnp.float32))


def _diff_attend_prompt(q, k, v, lam):
    B, T = q.shape[:2]
    nb = T // QBLOCK
    qb = q.reshape(B, nb, QBLOCK, 2 * DIFF_HEADS, DIFF_HD).swapaxes(0, 1)
    key_chunk = jnp.arange(T) // CHUNK

    def block(args):
        qblk, start = args
        q_chunk = (start + jnp.arange(QBLOCK)) // CHUNK
        mask = key_chunk[None, :] <= q_chunk[:, None]
        return _diff_attend(qblk, k, v, lam, mask)

    o = lax.map(block, (qb, jnp.arange(nb) * QBLOCK))
    return o.swapaxes(0, 1).reshape(B, T, DIFF_HEADS, 2 * DIFF_HD)


def _diff_output(o, z, lam_init, subln_w, w_out):
    B, T = o.shape[:2]
    o = _rmsnorm(o, subln_w) * (1.0 - lam_init)
    o = o.reshape(B, T, D_INNER).astype(z.dtype)
    return (o * jax.nn.silu(z)) @ w_out


def setup_inputs(seed: int = 0) -> dict:
    key = jax.random.key(seed)
    ks = jax.random.split(key, 24)

    def nrm(k, shape, scale=1.0):
        return jax.random.normal(k, shape, jnp.float32) * scale

    gla_cols = 2 * GLA_KD + 2 * D_INNER
    return {
        'x_prompt': nrm(ks[0], (BATCH, SEQ, D_MODEL)),
        'x_sample': nrm(ks[1], (DEC_BATCH, DEC_SEQ, D_MODEL)),
        'state_gla': nrm(ks[2], (N_GLA, DEC_BATCH, GLA_HEADS, GLA_DK, GLA_DV)),
        'state_hgrn': nrm(ks[3], (N_HGRN, DEC_BATCH, HGRN_HEADS, HGRN_DK, HGRN_DV), 0.5),
        'cache_k': nrm(ks[4], (N_DIFF, DEC_BATCH, PAST_LEN, 2 * DIFF_HEADS, DIFF_HD)),
        'cache_v': nrm(ks[5], (N_DIFF, DEC_BATCH, PAST_LEN, DIFF_HEADS, 2 * DIFF_HD)),
        'norm_w': 1.0 + nrm(ks[6], (DEPTH, D_MODEL), 0.02),
        'final_norm_w': 1.0 + nrm(ks[7], (D_MODEL,), 0.02),
        'gla_w_in': nrm(ks[8], (N_GLA, D_MODEL, gla_cols), D_MODEL ** -0.5),
        'gla_w_a1': nrm(ks[9], (N_GLA, D_MODEL, GLA_GATE_RANK), D_MODEL ** -0.5),
        'gla_w_a2': nrm(ks[10], (N_GLA, GLA_GATE_RANK, GLA_KD), GLA_GATE_RANK ** -0.5),
        'gla_b_a': nrm(ks[11], (N_GLA, GLA_KD), 0.1),
        'gla_norm_w': 1.0 + nrm(ks[12], (N_GLA, GLA_DV), 0.02),
        'gla_w_out': nrm(ks[13], (N_GLA, D_INNER, D_MODEL), D_INNER ** -0.5),
        'hgrn_w_in': nrm(ks[14], (N_HGRN, D_MODEL, 4 * D_INNER), D_MODEL ** -0.5),
        'hgrn_lower_bounds': nrm(ks[15], (DEPTH, D_INNER), 0.1),
        'hgrn_norm_w': 1.0 + nrm(ks[16], (N_HGRN, D_INNER), 0.02),
        'hgrn_w_out': nrm(ks[17], (N_HGRN, D_INNER, D_MODEL), D_INNER ** -0.5),
        'diff_w_in': nrm(ks[18], (N_DIFF, D_MODEL, 4 * D_INNER), D_MODEL ** -0.5),
        'diff_lambda': nrm(ks[19], (N_DIFF, 4, DIFF_HD), 0.1),
        'diff_subln_w': 1.0 + nrm(ks[20], (N_DIFF, 2 * DIFF_HD), 0.02),
        'diff_w_out': nrm(ks[21], (N_DIFF, D_INNER, D_MODEL), D_INNER ** -0.5),
    }


def reference(x_prompt, x_sample, state_gla, state_hgrn, cache_k, cache_v,
              norm_w, final_norm_w,
              gla_w_in, gla_w_a1, gla_w_a2, gla_b_a, gla_norm_w, gla_w_out,
              hgrn_w_in, hgrn_lower_bounds, hgrn_norm_w, hgrn_w_out,
              diff_w_in, diff_lambda, diff_subln_w, diff_w_out):
    lb = jax.nn.softmax(hgrn_lower_bounds.astype(jnp.float32), axis=0)
    lb = jnp.cumsum(lb, axis=0) - lb[0]

    xp, xs = x_prompt, x_sample
    Bp = xp.shape[0]
    gla_p, gla_s, hg_p, hg_s, kp_l, vp_l, ks_l, vs_l = [], [], [], [], [], [], [], []
    ia = ib = ic = 0
    for i in range(DEPTH):
        hp = _rmsnorm(xp, norm_w[i])
        hs = _rmsnorm(xs, norm_w[i])
        kind = i % N_MIXERS
        if kind == 0:
            j = ia
            ia += 1
            w = (gla_w_in[j], gla_w_a1[j], gla_w_a2[j], gla_b_a[j], gla_norm_w[j], gla_w_out[j])
            S0 = jnp.zeros((Bp, GLA_HEADS, GLA_DK, GLA_DV), jnp.float32)
            yp, Sp = _gla_branch(hp, S0, *w)
            ys, Ss = _gla_branch(hs, state_gla[j], *w)
            gla_p.append(Sp)
            gla_s.append(Ss)
        elif kind == 1:
            j = ib
            ib += 1
            w = (hgrn_w_in[j], hgrn_norm_w[j], hgrn_w_out[j])
            S0 = jnp.zeros((Bp, HGRN_HEADS, HGRN_DK, HGRN_DV), jnp.float32)
            yp, Sp = _hgrn2_branch(hp, S0, lb[i], *w)
            ys, Ss = _hgrn2_branch(hs, state_hgrn[j], lb[i], *w)
            hg_p.append(Sp)
            hg_s.append(Ss)
        else:
            j = ic
            ic += 1
            lam_init = 0.8 - 0.6 * math.exp(-0.3 * i)
            lam = _diff_lambda(diff_lambda[j], lam_init)
            qp, kp, vp, zp = _diff_project(hp, diff_w_in[j])
            op = _diff_attend_prompt(qp, kp, vp, lam)
            yp = _diff_output(op, zp, lam_init, diff_subln_w[j], diff_w_out[j])
            qs, kn, vn, zs = _diff_project(hs, diff_w_in[j])
            k_all = jnp.concatenate([cache_k[j].astype(kn.dtype), kn], axis=1)
            v_all = jnp.concatenate([cache_v[j].astype(vn.dtype), vn], axis=1)
            os_ = _diff_attend(qs, k_all, v_all, lam, None)
            ys = _diff_output(os_, zs, lam_init, diff_subln_w[j], diff_w_out[j])
            kp_l.append(kp)
            vp_l.append(vp)
            ks_l.append(kn)
            vs_l.append(vn)
        xp = xp + yp.astype(xp.dtype)
        xs = xs + ys.astype(xs.dtype)

    y_prompt = _rmsnorm(xp, final_norm_w)
    y_sample = _rmsnorm(xs, final_norm_w)
    gla_state_p = jnp.stack(gla_p)
    gla_state_s = jnp.stack(gla_s)
    hgrn_state_p = jnp.stack(hg_p)
    hgrn_state_s = jnp.stack(hg_s)
    k_rows_p = jnp.stack(kp_l)
    v_rows_p = jnp.stack(vp_l)
    k_rows_s = jnp.stack(ks_l)
    v_rows_s = jnp.stack(vs_l)
    return (y_prompt, y_sample, gla_state_p, gla_state_s, hgrn_state_p, hgrn_state_s,
            k_rows_p, v_rows_p, k_rows_s, v_rows_s)
```

```cpp
#include <hip/hip_runtime.h>
#include <hip/hip_cooperative_groups.h>
#include <cstdio>
namespace cg = cooperative_groups;

typedef unsigned short u16;
typedef unsigned int u32;
using bf16x8 = __attribute__((ext_vector_type(8))) short;
using f32x16 = __attribute__((ext_vector_type(16))) float;
using f32x4 = __attribute__((ext_vector_type(4))) float;
using u32x4 = __attribute__((ext_vector_type(4))) unsigned;
using u32x2 = __attribute__((ext_vector_type(2))) unsigned;

#define DI __device__ __forceinline__
#define MFMA(a, b, c) __builtin_amdgcn_mfma_f32_32x32x16_bf16((a), (b), (c), 0, 0, 0)
#define LAS __attribute__((address_space(3)))

constexpr int MROWS = 16640;
constexpr int PROWS = 16384;
constexpr int DM = 2048;
constexpr size_t OFF_GSP = 34078720;
constexpr size_t OFF_GSS = 38273024;
constexpr size_t OFF_HSP = 46661632;
constexpr size_t OFF_HSS = 47710208;
constexpr size_t OFF_KP = 49807360;
constexpr size_t OFF_VP = 83361792;
constexpr size_t OFF_KS = 116916224;
constexpr size_t OFF_VS = 117440512;
constexpr size_t WS_WIN = 0;
constexpr size_t WS_WOUT = 33554432;
constexpr size_t WS_H = 41943040;
constexpr size_t WS_PROJ = 110100480;
constexpr size_t WS_PREP = 382730240;
constexpr size_t WS_XW = 530874368;
constexpr size_t WS_BAR = 599031808;
constexpr size_t WS_RS = 599048192;
constexpr size_t WS_WOUT1 = 599314432;
constexpr size_t LDS_BYTES = 147456;
constexpr float LAM_INIT = 0.47071302f;
constexpr int GLA_LD = 6400;

struct Params {
  const float* x_prompt; const float* x_sample; const float* state_gla; const float* state_hgrn;
  const float* cache_k; const float* cache_v; const float* norm_w; const float* final_norm_w;
  const float* gla_w_in; const float* gla_w_a1; const float* gla_w_a2; const float* gla_b_a;
  const float* gla_norm_w; const float* gla_w_out;
  const float* hgrn_w_in; const float* hgrn_lb; const float* hgrn_norm_w; const float* hgrn_w_out;
  const float* diff_w_in; const float* diff_lambda; const float* diff_subln_w; const float* diff_w_out;
  float* out; char* ws;
};

typedef __bf16 bf16v2 __attribute__((ext_vector_type(2)));
typedef float f32v2 __attribute__((ext_vector_type(2)));
DI u32 pack2(float a, float b) { f32v2 v = {a, b}; return __builtin_bit_cast(u32, __builtin_convertvector(v, bf16v2)); }
DI u16 f2bf(float x) { return (u16)(pack2(x, 0.f) & 0xffffu); }
DI float bf2f(u16 b) { return __uint_as_float(((u32)b) << 16); }
DI float bflo(u32 p) { return __uint_as_float(p << 16); }
DI float bfhi(u32 p) { return __uint_as_float(p & 0xffff0000u); }
DI bf16x8 ld16(const u16* p) { return *reinterpret_cast<const bf16x8*>(p); }
DI bf16x8 ld8x2(const u16* p0, const u16* p1) {
  u32x2 a = *reinterpret_cast<const u32x2*>(p0); u32x2 b = *reinterpret_cast<const u32x2*>(p1);
  u32x4 r = {a.x, a.y, b.x, b.y}; return __builtin_bit_cast(bf16x8, r);
}
DI int opq(int x) { asm volatile("" : "+v"(x)); return x; }
DI int crow(int reg, int hh) { return (reg & 3) + 8 * (reg >> 2) + 4 * hh; }
template <int S> DI bf16x8 packacc(const f32x16& x) {
  u32x4 r = {pack2(x[8 * S], x[8 * S + 1]), pack2(x[8 * S + 2], x[8 * S + 3]), pack2(x[8 * S + 4], x[8 * S + 5]), pack2(x[8 * S + 6], x[8 * S + 7])};
  return __builtin_bit_cast(bf16x8, r);
}
DI float wave_sum(float v) {
#pragma unroll
  for (int o = 32; o > 0; o >>= 1) v += __shfl_xor(v, o);
  return v;
}
DI f32x16 zero16() { f32x16 z;
#pragma unroll
  for (int i = 0; i < 16; ++i) z[i] = 0.f;
  return z; }

DI void conv_job(const float* W, int ldw, int ncols, u16* Wt, int drow0, int rank, int nranks) {
  const int tid = opq(threadIdx.x), lane = tid & 63, wv = tid >> 6;
  const int ntn = (ncols + 63) >> 6;
  const int ntiles = 64 * ntn;
  for (int tile = rank * 8 + wv; tile < ntiles; tile += nranks * 8) {
    const int tn = tile % ntn, tk = tile / ntn;
    const int n = tn * 64 + lane, k0 = tk * 32;
    if (n < ncols) {
      const float* src = W + (size_t)k0 * ldw + n;
      float v[32];
#pragma unroll
      for (int i = 0; i < 32; ++i) v[i] = src[(size_t)i * ldw];
      u32x4* dst = reinterpret_cast<u32x4*>(Wt + (size_t)(drow0 + n) * 2048 + k0);
#pragma unroll
      for (int i = 0; i < 4; ++i) {
        u32x4 o = {pack2(v[8 * i], v[8 * i + 1]), pack2(v[8 * i + 2], v[8 * i + 3]), pack2(v[8 * i + 4], v[8 * i + 5]), pack2(v[8 * i + 6], v[8 * i + 7])};
        dst[i] = o;
      }
    }
  }
}

DI void norm_phase(const float* xp, const float* xs, const float* w, u16* h) {
  const int tid = opq(threadIdx.x); const int lane = tid & 63, wv = tid >> 6;
  for (int row = blockIdx.x * 8 + wv; row < MROWS; row += gridDim.x * 8) {
    const float* src = row < PROWS ? xp + (size_t)row * DM : xs + (size_t)(row - PROWS) * DM;
    float4 v[8]; float ss = 0.f;
#pragma unroll
    for (int i = 0; i < 8; ++i) { v[i] = reinterpret_cast<const float4*>(src)[i * 64 + lane]; ss += v[i].x * v[i].x + v[i].y * v[i].y + v[i].z * v[i].z + v[i].w * v[i].w; }
    ss = wave_sum(ss);
    const float r = rsqrtf(ss * (1.f / 2048.f) + 1e-6f);
    u32x2* dst = reinterpret_cast<u32x2*>(h + (size_t)row * DM);
#pragma unroll
    for (int i = 0; i < 8; ++i) {
      const float4 ww = reinterpret_cast<const float4*>(w)[i * 64 + lane];
      u32x2 o = {pack2(v[i].x * r * ww.x, v[i].y * r * ww.y), pack2(v[i].z * r * ww.z, v[i].w * r * ww.w)};
      dst[i * 64 + lane] = o;
    }
  }
}

DI void final_norm_phase(float* y, const float* w, const float* rs) {
  const int tid = opq(threadIdx.x); const int lane = tid & 63, wv = tid >> 6;
  for (int row = blockIdx.x * 8 + wv; row < MROWS; row += gridDim.x * 8) {
    float4* src = reinterpret_cast<float4*>(y + (size_t)row * DM);
    const float r = rsqrtf(rs[row] * (1.f / 2048.f) + 1e-6f);
#pragma unroll
    for (int i = 0; i < 8; ++i) {
      const float4 v = src[i * 64 + lane];
      const float4 ww = reinterpret_cast<const float4*>(w)[i * 64 + lane];
      float4 o = {v.x * r * ww.x, v.y * r * ww.y, v.z * r * ww.z, v.w * r * ww.w};
      src[i * 64 + lane] = o;
    }
  }
}

namespace pg8 {
constexpr int BM = 256, BK = 64, HALF = 128, HTB = HALF * BK * 2, NXCD = 8, WGM = 8;
DI int lds_byte(int r, int c) { const int st = (r >> 4) * 2 + (c >> 5), rr = r & 15, cc = c & 31, ob = rr * 64 + cc * 2; return st * 1024 + (ob ^ (((ob >> 9) & 1) << 5)); }
DI void stage_rc(int b, int& R, int& C) { const int st = b / 1024, sb = b % 1024, swz = sb ^ (((sb >> 9) & 1) << 5); R = (st >> 1) * 16 + swz / 64; C = (st & 1) * 32 + (swz % 64) / 2; }
DI int perm32(int rho) { const int n = rho >> 4, i = rho & 15; return 8 * (i >> 2) + 4 * n + (i & 3); }
struct Unit { int pm, pn; };
struct Gemm { const u16* A; const u16* Bt; int M, N, K; };
struct StaticOrder {
  int nM, nN, nwg, G, c;
  DI void init(int M, int N, int G_, int c_) { nM = M / BM; nN = N / BM; nwg = nM * nN; G = G_; c = c_; }
  DI bool next(int i, Unit& u) const {
    const long L = (long)i * G + c; if (L >= nwg) return false;
    int wgid = (int)L; { const int q = nwg / NXCD, r = nwg % NXCD, xcd = wgid % NXCD, off = wgid / NXCD; wgid = (xcd < r ? xcd * (q + 1) : r * (q + 1) + (xcd - r) * q) + off; }
    const int nig = WGM * nN, gid = wgid / nig, fm = gid * WGM, gsz = (nM - fm) < WGM ? (nM - fm) : WGM;
    u.pm = fm + ((wgid % nig) % gsz); u.pn = (wgid % nig) / gsz; return true;
  }
};

template <class Epi>
DI void gemm_phase(LAS unsigned char* lds, const Gemm g, const StaticOrder& S, const Epi& E) {
  const int tid = opq(threadIdx.x), wid = __builtin_amdgcn_readfirstlane(tid >> 6), lane = tid & 63, wr = wid >> 2, wc = wid & 3, fr = lane & 15, fq = lane >> 4;
  const int K = g.K, nt = K / BK;
  unsigned voffA[2], voffB[2];
#pragma unroll
  for (int i = 0; i < 2; ++i) { int R, C; stage_rc(tid * 16 + i * 8192, R, C); const int Rb = Epi::PERM ? ((R & ~31) + perm32(R & 31)) : R;
    voffA[i] = (unsigned)(R * K + C) * 2u; voffB[i] = (unsigned)(Rb * K + C) * 2u; }
  const size_t kstep = (size_t)(BK * 2);
  const size_t hstep = (size_t)HALF * K * 2;
  const size_t tstep = 2 * hstep;
  const unsigned ldsw = (unsigned)wid * 1024u;
  const int aoff = lds_byte(wr * 64 + fr, fq * 8), boff = lds_byte(wc * 32 + fr, fq * 8);
#define PG8_SA(b, h) (((b) * 2 + (h)) * HTB)
#define PG8_SB(b, h) ((4 + (b) * 2 + (h)) * HTB)
#define PG8_STAGE(bufoff, gbase, voff) do { _Pragma("unroll") for (int _i = 0; _i < 2; ++_i) \
    __builtin_amdgcn_global_load_lds((const unsigned*)((const char*)(gbase) + (voff)[_i]), (LAS unsigned*)(lds + (bufoff) + ldsw + _i * 8192), 16, 0, 0); } while (0)
#define PG8_LDA(dst, b, h) do { _Pragma("unroll") for (int m = 0; m < 4; ++m) _Pragma("unroll") for (int k = 0; k < 2; ++k) dst[m][k] = *(const LAS bf16x8*)(lds + PG8_SA(b, h) + aoff + m * 2048 + k * 1024); } while (0)
#define PG8_LDB(dst, b, h) do { _Pragma("unroll") for (int n = 0; n < 2; ++n) _Pragma("unroll") for (int k = 0; k < 2; ++k) dst[n][k] = *(const LAS bf16x8*)(lds + PG8_SB(b, h) + boff + n * 2048 + k * 1024); } while (0)
#define PG8_MMA(ai, bj, At, Bt) do { __builtin_amdgcn_s_setprio(1); _Pragma("unroll") for (int m = 0; m < 4; ++m) _Pragma("unroll") for (int n = 0; n < 2; ++n) _Pragma("unroll") for (int k = 0; k < 2; ++k) \
    acc[ai][bj][m][n] = __builtin_amdgcn_mfma_f32_16x16x32_bf16(Bt[n][k], At[m][k], acc[ai][bj][m][n], 0, 0, 0); __builtin_amdgcn_s_setprio(0); } while (0)
#define PG8_WAIT_V(n) asm volatile("s_waitcnt vmcnt(" #n ")" ::: "memory")
#define PG8_WAIT_L(n) asm volatile("s_waitcnt lgkmcnt(" #n ")" ::: "memory")
#define PG8_BAR __builtin_amdgcn_s_barrier()
#define PG8_SCHED __builtin_amdgcn_sched_barrier(0)
  Unit cur, nxt; int ui = 0;
  if (!S.next(0, cur)) return;
  f32x4 acc[2][2][4][2];
#pragma unroll
  for (int a = 0; a < 2; ++a)
#pragma unroll
    for (int b = 0; b < 2; ++b)
#pragma unroll
      for (int m = 0; m < 4; ++m)
#pragma unroll
        for (int n = 0; n < 2; ++n) acc[a][b][m][n] = (f32x4){0.f, 0.f, 0.f, 0.f};
  bf16x8 At[4][2], B0[2][2], B1[2][2];
  const char* cA = (const char*)g.A + (size_t)cur.pm * tstep; const char* cB = (const char*)g.Bt + (size_t)cur.pn * tstep;
  PG8_STAGE(PG8_SB(0, 0), cB, voffB); PG8_STAGE(PG8_SA(0, 0), cA, voffA); PG8_STAGE(PG8_SB(0, 1), cB + hstep, voffB); PG8_STAGE(PG8_SA(0, 1), cA + hstep, voffA);
  if (wr == 1) PG8_BAR;
  PG8_WAIT_V(4); PG8_BAR;
  PG8_STAGE(PG8_SB(1, 0), cB + kstep, voffB); PG8_STAGE(PG8_SA(1, 0), cA + kstep, voffA); PG8_STAGE(PG8_SB(1, 1), cB + hstep + kstep, voffB);
  PG8_WAIT_V(6); PG8_BAR;
  for (;;) {
    const bool has_next = S.next(ui + 1, nxt);
    const char* nA = has_next ? (const char*)g.A + (size_t)nxt.pm * tstep : cA; const char* nB = has_next ? (const char*)g.Bt + (size_t)nxt.pn * tstep : cB;
    for (int t = 0; t < nt; t += 2) {
      const bool last = (t == nt - 2);
      const char* a1 = cA + (size_t)(t + 1) * kstep;
      const char* a2 = last ? nA : cA + (size_t)(t + 2) * kstep; const char* b2 = last ? nB : cB + (size_t)(t + 2) * kstep;
      const char* a3 = a2 + kstep; const char* b3 = b2 + kstep;
      PG8_LDB(B0, 0, 0); PG8_SCHED; PG8_LDA(At, 0, 0); PG8_STAGE(PG8_SA(1, 1), a1 + hstep, voffA);
      PG8_WAIT_L(8); PG8_BAR; PG8_WAIT_L(0); PG8_MMA(0, 0, At, B0); PG8_BAR; PG8_SCHED;
      PG8_LDB(B1, 0, 1); PG8_STAGE(PG8_SB(0, 0), b2, voffB);
      PG8_BAR; PG8_WAIT_L(0); PG8_MMA(0, 1, At, B1); PG8_BAR;
      PG8_LDA(At, 0, 1); PG8_STAGE(PG8_SA(0, 0), a2, voffA);
      PG8_BAR; PG8_WAIT_L(0); PG8_MMA(1, 0, At, B0); PG8_BAR; PG8_SCHED;
      PG8_STAGE(PG8_SB(0, 1), b2 + hstep, voffB);
      PG8_WAIT_V(6); PG8_BAR; PG8_MMA(1, 1, At, B1); PG8_BAR;
      PG8_LDB(B0, 1, 0); PG8_SCHED; PG8_LDA(At, 1, 0); PG8_STAGE(PG8_SA(0, 1), a2 + hstep, voffA);
      PG8_WAIT_L(8); PG8_BAR; PG8_WAIT_L(0); PG8_MMA(0, 0, At, B0); PG8_BAR; PG8_SCHED;
      PG8_LDB(B1, 1, 1); PG8_STAGE(PG8_SB(1, 0), b3, voffB);
      PG8_BAR; PG8_WAIT_L(0); PG8_MMA(0, 1, At, B1); PG8_BAR;
      PG8_LDA(At, 1, 1); PG8_STAGE(PG8_SA(1, 0), a3, voffA);
      PG8_BAR; PG8_WAIT_L(0); PG8_MMA(1, 0, At, B0); PG8_BAR; PG8_SCHED;
      PG8_STAGE(PG8_SB(1, 1), b3 + hstep, voffB);
      PG8_WAIT_V(6); PG8_BAR; PG8_MMA(1, 1, At, B1); PG8_BAR;
    }
    E(acc, cur, wr, wc, fr, fq);
    if (!has_next) break;
#pragma unroll
    for (int a = 0; a < 2; ++a)
#pragma unroll
      for (int b = 0; b < 2; ++b)
#pragma unroll
        for (int m = 0; m < 4; ++m)
#pragma unroll
          for (int n = 0; n < 2; ++n) acc[a][b][m][n] = (f32x4){0.f, 0.f, 0.f, 0.f};
    cur = nxt; cA = nA; cB = nB; ++ui;
  }
  PG8_WAIT_V(0);
  if (wr == 0) PG8_BAR;
  PG8_BAR;
#undef PG8_SA
#undef PG8_SB
#undef PG8_STAGE
#undef PG8_LDA
#undef PG8_LDB
#undef PG8_MMA
#undef PG8_WAIT_V
#undef PG8_WAIT_L
#undef PG8_BAR
#undef PG8_SCHED
}

struct EpiProj {
  static constexpr bool PERM = true;
  u16* O; int ldc; float* out; int mode; const float* rs;
  DI void operator()(const f32x4 (&acc)[2][2][4][2], const Unit& u, int wr, int wc, int fr, int fq) const {
    const int row0 = u.pm * BM + wr * 64 + fr, colt = u.pn * BM, col0 = colt + wc * 32 + 8 * fq;
    const bool kv = (mode == 1) && colt >= 2048 && colt < 6144;
    const int sec = colt >= 4096 ? 1 : 0;
#pragma unroll
    for (int ai = 0; ai < 2; ++ai)
#pragma unroll
      for (int m = 0; m < 4; ++m) {
        const int row = row0 + ai * HALF + m * 16;
        u16* rowp = O + (size_t)row * ldc + col0;
        const float rr = rs ? rsqrtf(rs[row] * (1.f / 2048.f) + 1e-6f) : 1.f;
#pragma unroll
        for (int bj = 0; bj < 2; ++bj) {
          const f32x4 v0 = acc[ai][bj][m][0] * rr, v1 = acc[ai][bj][m][1] * rr;
          u32x4 w = {pack2(v0[0], v0[1]), pack2(v0[2], v0[3]), pack2(v1[0], v1[1]), pack2(v1[2], v1[3])};
          *reinterpret_cast<u32x4*>(rowp + bj * HALF) = w;
          if (kv) {
            const int c2 = col0 + bj * HALF - 2048 - sec * 2048;
            float* dst = row < PROWS ? out + (sec ? OFF_VP : OFF_KP) + (size_t)row * DM + c2 : out + (sec ? OFF_VS : OFF_KS) + (size_t)(row - PROWS) * DM + c2;
            *reinterpret_cast<f32x4*>(dst) = v0; *reinterpret_cast<f32x4*>(dst + 4) = v1;
          }
        }
      }
  }
};
struct EpiRes {
  static constexpr bool PERM = true;
  const float* xp; const float* xs; float* out; int layer; const float* wn; u16* xw; float* rs;
  DI void operator()(const f32x4 (&acc)[2][2][4][2], const Unit& u, int wr, int wc, int fr, int fq) const {
    const int row0 = u.pm * BM + wr * 64 + fr, col0 = u.pn * BM + wc * 32 + 8 * fq;
    f32x4 wv[2][2];
#pragma unroll
    for (int bj = 0; bj < 2; ++bj)
#pragma unroll
      for (int n = 0; n < 2; ++n) wv[bj][n] = xw ? *reinterpret_cast<const f32x4*>(wn + col0 + bj * HALF + n * 4) : (f32x4){0.f, 0.f, 0.f, 0.f};
#pragma unroll
    for (int ai = 0; ai < 2; ++ai)
#pragma unroll
      for (int m = 0; m < 4; ++m) {
        const int row = row0 + ai * HALF + m * 16;
        float* dst = out + (size_t)row * DM + col0;
        const float* src = layer == 0 ? (row < PROWS ? xp + (size_t)row * DM + col0 : xs + (size_t)(row - PROWS) * DM + col0) : dst;
        float ss = 0.f;
#pragma unroll
        for (int bj = 0; bj < 2; ++bj) {
          const f32x4 x0 = *reinterpret_cast<const f32x4*>(src + bj * HALF), x1 = *reinterpret_cast<const f32x4*>(src + bj * HALF + 4);
          const f32x4 n0 = x0 + acc[ai][bj][m][0], n1 = x1 + acc[ai][bj][m][1];
          *reinterpret_cast<f32x4*>(dst + bj * HALF) = n0; *reinterpret_cast<f32x4*>(dst + bj * HALF + 4) = n1;
          ss += n0[0] * n0[0] + n0[1] * n0[1] + n0[2] * n0[2] + n0[3] * n0[3] + n1[0] * n1[0] + n1[1] * n1[1] + n1[2] * n1[2] + n1[3] * n1[3];
          if (xw) {
            const f32x4 h0 = n0 * wv[bj][0], h1 = n1 * wv[bj][1];
            u32x4 pk = {pack2(h0[0], h0[1]), pack2(h0[2], h0[3]), pack2(h1[0], h1[1]), pack2(h1[2], h1[3])};
            *reinterpret_cast<u32x4*>(xw + (size_t)row * DM + col0 + bj * HALF) = pk;
          }
        }
        ss += __shfl_xor(ss, 16); ss += __shfl_xor(ss, 32);
        if (fq == 0) atomicAdd(rs + row, ss);
      }
  }
};
}

template <class Epi>
DI void gemm8(char* smem, const u16* A, const u16* Bt, int N, const Epi& E) {
  pg8::Gemm g; g.A = A; g.Bt = Bt; g.M = MROWS; g.N = N; g.K = 2048;
  pg8::StaticOrder S; S.init(MROWS, N, gridDim.x, blockIdx.x);
  pg8::gemm_phase<Epi>((LAS unsigned char*)smem, g, S, E);
}

template <int KIND> struct RC {
  static constexpr int H = KIND == 0 ? 4 : 16;
  static constexpr int KH = KIND == 0 ? 256 : 128;
  static constexpr int VH = KIND == 0 ? 512 : 128;
  static constexpr int HPB = 256 / KH;
  static constexpr int LD = KIND == 0 ? GLA_LD : 8192;
  static constexpr int NIT = 264 * H;
  static constexpr int VOFF = KIND == 0 ? 2048 : 4096;
  static constexpr size_t SZQ = (size_t)NIT * 64 * KH;
  static constexpr size_t SZV = (size_t)NIT * VH * 64;
};

template <int KIND>
DI void prep_phase(const Params& p, int layer, int j, const u16* proj, char* prep, char* smem) {
  using C = RC<KIND>;
  constexpr int H = C::H, KH = C::KH, VH = C::VH, HPB = C::HPB, LD = C::LD, KTH = KH / 32;
  constexpr float L2E = 1.4426950408889634f, LN2 = 0.6931471805599453f;
  u16* QF = reinterpret_cast<u16*>(prep);
  u16* KF = QF + C::SZQ;
  u16* VF = KF + C::SZQ;
  u16* AF = VF + C::SZV;
  float* DL = reinterpret_cast<float*>(AF + (size_t)C::NIT * 4096);
  const int tid = opq(threadIdx.x), half = tid >> 8, c = tid & 255, lane = tid & 63, wvl = (tid >> 6) & 3, l31 = lane & 31, hh = lane >> 5;
  u16* qs = reinterpret_cast<u16*>(smem) + half * (2 * 64 * 264 + 64 * 16);
  u16* ks = qs + 64 * 264;
  u16* as = ks + 64 * 264;
  constexpr int HG = H / HPB;
  const int nblk = 264 * HG;
  for (int bi = blockIdx.x * 2 + half; bi < nblk; bi += gridDim.x * 2) {
    const int cgk = bi / HG, hg = bi - cgk * HG;
    const int nvalid = cgk < 256 ? 64 : 32;
    const size_t row0 = cgk < 256 ? (size_t)cgk * 64 : (size_t)PROWS + (size_t)(cgk - 256) * 32;
    const int head = hg * HPB + c / KH, kk = c % KH;
    const int item = cgk * H + head;
    float w2[16]; float ba = 0.f, lb = 0.f;
    if (KIND == 0) {
#pragma unroll
      for (int r = 0; r < 16; ++r) w2[r] = p.gla_w_a2[(size_t)j * 16 * 1024 + r * 1024 + head * 256 + kk];
      ba = p.gla_b_a[j * 1024 + head * 256 + kk];
    } else {
#pragma unroll
      for (int r = 0; r < 16; ++r) w2[r] = 0.f;
      const int ch = head * 128 + kk;
      float l0 = p.hgrn_lb[ch], l1 = p.hgrn_lb[2048 + ch], l2 = p.hgrn_lb[4096 + ch], l3 = p.hgrn_lb[6144 + ch];
      float mx = fmaxf(fmaxf(l0, l1), fmaxf(l2, l3));
      float e0 = expf(l0 - mx), e1 = expf(l1 - mx), e2 = expf(l2 - mx), e3 = expf(l3 - mx);
      float inv = 1.f / (e0 + e1 + e2 + e3);
      float acc = 0.f;
      if (layer >= 1) acc += e1;
      if (layer >= 2) acc += e2;
      if (layer >= 3) acc += e3;
      lb = acc * inv;
    }
    __syncthreads();
    {
      const u16* qsrc = proj + row0 * LD + hg * 256;
      const u16* ksrc = qsrc + (KIND == 0 ? 1024 : 2048);
#pragma unroll
      for (int i = 0; i < 8; ++i) {
        const int id = c + 256 * i, t = id >> 5, ch = id & 31;
        u32x4 vq = {0u, 0u, 0u, 0u}, vk = {0u, 0u, 0u, 0u};
        if (t < nvalid) {
          vq = *reinterpret_cast<const u32x4*>(qsrc + (size_t)t * LD + ch * 8);
          vk = *reinterpret_cast<const u32x4*>(ksrc + (size_t)t * LD + ch * 8);
        }
        *reinterpret_cast<u32x4*>(qs + t * 264 + ch * 8) = vq;
        *reinterpret_cast<u32x4*>(ks + t * 264 + ch * 8) = vk;
      }
      if (KIND == 0 && c < 128) {
        const int t = c >> 1, part = c & 1;
        u32x4 va = {0u, 0u, 0u, 0u};
        if (t < nvalid) va = *reinterpret_cast<const u32x4*>(proj + (row0 + t) * LD + 6144 + part * 8);
        *reinterpret_cast<u32x4*>(as + t * 16 + part * 8) = va;
      }
    }
    __syncthreads();
    float b = 0.f;
    {
      const int kt = kk >> 5, kl = kk & 31;
      u16* kfb = KF + (size_t)item * 64 * KH + ((size_t)(kt * 4) * 64 + kl) * 8;
#pragma unroll 2
      for (int t8 = 0; t8 < 8; ++t8) {
        u32 pk[4];
#pragma unroll
        for (int e = 0; e < 4; ++e) {
          u16 kb[2];
#pragma unroll
          for (int q = 0; q < 2; ++q) {
            const int t = t8 * 8 + 2 * e + q;
            const float qr = bf2f(qs[t * 264 + c]), kr = bf2f(ks[t * 264 + c]);
            float qv, kv, g;
            if (KIND == 0) {
              qv = qr * 0.0625f; kv = kr;
              const u32x4 a0 = *reinterpret_cast<const u32x4*>(as + t * 16);
              const u32x4 a1 = *reinterpret_cast<const u32x4*>(as + t * 16 + 8);
              float x = ba;
              x += bflo(a0.x) * w2[0] + bfhi(a0.x) * w2[1] + bflo(a0.y) * w2[2] + bfhi(a0.y) * w2[3];
              x += bflo(a0.z) * w2[4] + bfhi(a0.z) * w2[5] + bflo(a0.w) * w2[6] + bfhi(a0.w) * w2[7];
              x += bflo(a1.x) * w2[8] + bfhi(a1.x) * w2[9] + bflo(a1.y) * w2[10] + bfhi(a1.y) * w2[11];
              x += bflo(a1.z) * w2[12] + bfhi(a1.z) * w2[13] + bflo(a1.w) * w2[14] + bfhi(a1.w) * w2[15];
              const float ex = __builtin_amdgcn_exp2f(-fabsf(x) * L2E);
              g = (fminf(x, 0.f) - __builtin_amdgcn_logf(1.f + ex) * LN2) * 0.0625f;
            } else {
              qv = qr / (1.f + __builtin_amdgcn_exp2f(-qr * L2E)) * 0.08838834764831845f;
              const float sg = 1.f / (1.f + __builtin_amdgcn_exp2f(-kr * L2E));
              const float fg = lb + (1.f - lb) * sg;
              kv = 1.f - fg;
              g = __builtin_amdgcn_logf(fg) * LN2;
            }
            if (t >= nvalid) { qv = 0.f; kv = 0.f; g = 0.f; }
            b += g;
            qs[t * 264 + c] = f2bf(qv * __builtin_amdgcn_exp2f(b * L2E));
            kb[q] = f2bf(kv * __builtin_amdgcn_exp2f(fminf(-b, 80.f) * L2E));
            ks[t * 264 + c] = kb[q];
          }
          pk[e] = (u32)kb[0] | ((u32)kb[1] << 16);
        }
        u32x4 o = {pk[0], pk[1], pk[2], pk[3]};
        *reinterpret_cast<u32x4*>(kfb + ((size_t)((t8 >> 1) * 64 + (t8 & 1) * 32)) * 8) = o;
      }
    }
    DL[(size_t)item * KH + kk] = __builtin_amdgcn_exp2f(b * L2E);
    __syncthreads();
    for (int jb = wvl; jb < HPB * 4; jb += 4) {
      const int hl = jb >> 2, tr = (jb >> 1) & 1, tc = jb & 1;
      f32x16 acc = zero16();
      if (!(tr == 0 && tc == 1)) {
#pragma unroll
        for (int s = 0; s < KH / 16; ++s) {
          bf16x8 a = ld16(qs + (tr * 32 + l31) * 264 + hl * KH + s * 16 + hh * 8);
          bf16x8 bb = ld16(ks + (tc * 32 + l31) * 264 + hl * KH + s * 16 + hh * 8);
          acc = MFMA(a, bb, acc);
        }
      }
      u16* am = AF + (size_t)(cgk * H + hg * HPB + hl) * 4096;
      const int scol = tc * 32 + l31;
      const int s16 = scol >> 4, hs = (scol >> 3) & 1, jj = scol & 7;
#pragma unroll
      for (int reg = 0; reg < 16; ++reg) {
        const int tl = crow(reg, hh), t = tr * 32 + tl;
        am[((tr * 4 + s16) * 64 + hs * 32 + tl) * 8 + jj] = f2bf(scol <= t ? acc[reg] : 0.f);
      }
    }
#pragma unroll
    for (int i = 0; i < 8; ++i) {
      const int f = c + 256 * i, fl = f & 63, fi = f >> 6;
      const int mt = fi & 1, s = (fi >> 1) & 1, ktg = fi >> 2;
      const int hl = ktg / KTH, kt = ktg % KTH;
      const int t = mt * 32 + (fl & 31), fh = fl >> 5;
      const u16* src = qs + t * 264 + ktg * 32 + 16 * s + 4 * fh;
      const bf16x8 v = ld8x2(src, src + 8);
      *reinterpret_cast<bf16x8*>(QF + (size_t)(cgk * H + hg * HPB + hl) * 64 * KH + ((size_t)(((kt * 2 + s) * 2 + mt) * 64 + fl)) * 8) = v;
    }
#pragma unroll 1
    for (int pc = 0; pc < HPB * VH / 256; ++pc) {
      __syncthreads();
      {
        const u16* vsrc = proj + row0 * LD + C::VOFF + (hg * HPB) * VH + pc * 256;
#pragma unroll
        for (int i = 0; i < 8; ++i) {
          const int id = c + 256 * i, t = id >> 5, ch = id & 31;
          u32x4 vv = {0u, 0u, 0u, 0u};
          if (t < nvalid) vv = *reinterpret_cast<const u32x4*>(vsrc + (size_t)t * LD + ch * 8);
          *reinterpret_cast<u32x4*>(qs + t * 264 + ch * 8) = vv;
        }
      }
      __syncthreads();
      const int cv = pc * 256 + c;
      const int hl = cv / VH, v = cv % VH;
      u16* dst = VF + (size_t)(cgk * H + hg * HPB + hl) * VH * 64 + ((size_t)((v >> 5) * 4) * 64 + (v & 31)) * 8;
#pragma unroll
      for (int t8 = 0; t8 < 8; ++t8) {
        u32 pk[4];
#pragma unroll
        for (int e = 0; e < 4; ++e) {
          const int t = t8 * 8 + 2 * e;
          pk[e] = (u32)qs[t * 264 + c] | ((u32)qs[(t + 1) * 264 + c] << 16);
        }
        u32x4 o = {pk[0], pk[1], pk[2], pk[3]};
        *reinterpret_cast<u32x4*>(dst + ((size_t)((t8 >> 1) * 64 + (t8 & 1) * 32)) * 8) = o;
      }
    }
  }
}

template <int NA_> struct SeqOps { bf16x8 q[2][2]; bf16x8 k[4]; bf16x8 v[4]; bf16x8 a[NA_]; float4 dl[4]; };

template <int KIND>
DI void seq_phase(const Params& p, int j, const char* prep, u16* obuf, char* smem) {
  using C = RC<KIND>;
  constexpr int H = C::H, KH = C::KH, VH = C::VH, WPI = KH / 32, IPB = 8 / WPI, NA = 8 / WPI, NVS = VH / 32, NV = 32 / WPI;
  const u16* QF = reinterpret_cast<const u16*>(prep);
  const u16* KF = QF + C::SZQ;
  const u16* VF = KF + C::SZQ;
  const u16* AF = VF + C::SZV;
  const float* DL = reinterpret_cast<const float*>(AF + (size_t)C::NIT * 4096);
  float* red = reinterpret_cast<float*>(smem);
  const int tid = opq(threadIdx.x), lane = tid & 63, wv = __builtin_amdgcn_readfirstlane(tid >> 6), l31 = lane & 31, hh = lane >> 5;
  const int grp = wv / WPI, wg = wv % WPI, kt = wg;
  constexpr int nitems = 12 * H * NVS, nbitems = nitems / IPB;
  constexpr size_t SSZ = (size_t)H * KH * VH;
  int cnt = 0;
  for (int bitem = blockIdx.x; bitem < nbitems; bitem += gridDim.x) {
    int bsel = bitem;
    {
      constexpr int PER_BH = NVS / IPB, NBH = 4 * H, NPB = NBH * PER_BH;
      if (bitem < NPB) { const int x = bitem & 7, i = bitem >> 3; bsel = (x * (NBH / 8) + i / PER_BH) * PER_BH + i % PER_BH; }
    }
    const int it = bsel * IPB + grp;
    const int seq = it / (H * NVS), rem = it % (H * NVS), head = rem / NVS, vs = rem % NVS;
    const size_t sbase = (size_t)head * KH * VH + (size_t)(kt * 32) * VH + vs * 32 + l31;
    float* st_out;
    if (KIND == 0) st_out = seq < 4 ? p.out + OFF_GSP + (size_t)(j * 4 + seq) * SSZ : p.out + OFF_GSS + (size_t)(j * 8 + seq - 4) * SSZ;
    else st_out = seq < 4 ? p.out + OFF_HSP + (size_t)seq * SSZ : p.out + OFF_HSS + (size_t)(seq - 4) * SSZ;
    f32x16 S;
    if (seq >= 4) {
      const float* st_in = (KIND == 0 ? p.state_gla + (size_t)j * 8 * SSZ : p.state_hgrn) + (size_t)(seq - 4) * SSZ;
#pragma unroll
      for (int reg = 0; reg < 16; ++reg) S[reg] = st_in[sbase + (size_t)crow(reg, hh) * VH];
    } else {
      S = zero16();
    }
    const int nch = seq < 4 ? 64 : 1;
    const int cg0 = seq < 4 ? seq * 64 : 256 + seq - 4;
    const int nvalid = seq < 4 ? 64 : 32;
    SeqOps<NA> cur, nxt;
    auto load_ops = [&](SeqOps<NA>& o, int cgk) {
      const size_t item = (size_t)cgk * H + head;
      const u16* qb = QF + item * 64 * KH + (size_t)(kt * 4) * 512 + lane * 8;
#pragma unroll
      for (int s = 0; s < 2; ++s)
#pragma unroll
        for (int mt = 0; mt < 2; ++mt) o.q[s][mt] = ld16(qb + (s * 2 + mt) * 512);
      const u16* kb = KF + item * 64 * KH + (size_t)(kt * 4) * 512 + lane * 8;
#pragma unroll
      for (int s16 = 0; s16 < 4; ++s16) o.k[s16] = ld16(kb + s16 * 512);
      const u16* vb = VF + item * VH * 64 + (size_t)(vs * 4) * 512 + lane * 8;
#pragma unroll
      for (int s16 = 0; s16 < 4; ++s16) o.v[s16] = ld16(vb + s16 * 512);
#pragma unroll
      for (int i = 0; i < NA; ++i) o.a[i] = ld16(AF + item * 4096 + (size_t)(wg * NA + i) * 512 + lane * 8);
      const float* db = DL + item * KH + kt * 32 + 4 * hh;
#pragma unroll
      for (int g4 = 0; g4 < 4; ++g4) o.dl[g4] = *reinterpret_cast<const float4*>(db + 8 * g4);
    };
    load_ops(cur, cg0);
    constexpr bool DEFER = true;
    u32 osum[NV / 2];
    auto store_o = [&](size_t prow0) {
#pragma unroll
      for (int i = 0; i < NV; ++i) {
        const int vec = wg * NV + i;
        const int t = (vec >> 4) * 32 + crow(vec & 15, hh);
        if (t < nvalid) obuf[(prow0 + t) * DM + head * VH + vs * 32 + l31] = (u16)((i & 1) ? (osum[i >> 1] >> 16) : (osum[i >> 1] & 0xffffu));
      }
    };
    for (int ch = 0; ch < nch; ++ch) {
      if (DEFER && ch > 0) store_o((size_t)(cg0 + ch - 1) * 64);
      if (ch + 1 < nch) load_ops(nxt, cg0 + ch + 1);
      const size_t row0 = seq < 4 ? (size_t)(cg0 + ch) * 64 : (size_t)PROWS + (size_t)(seq - 4) * 32;
      f32x16 O[2]; O[0] = zero16(); O[1] = zero16();
      {
        const bf16x8 b0 = packacc<0>(S), b1 = packacc<1>(S);
        O[0] = MFMA(cur.q[0][0], b0, O[0]);
        O[1] = MFMA(cur.q[0][1], b0, O[1]);
        O[0] = MFMA(cur.q[1][0], b1, O[0]);
        O[1] = MFMA(cur.q[1][1], b1, O[1]);
      }
#pragma unroll
      for (int i = 0; i < NA; ++i) {
        const int pi = wg * NA + i;
#pragma unroll
        for (int mc = 0; mc < 2; ++mc)
#pragma unroll
          for (int sc = 0; sc < 4; ++sc)
            if (pi == mc * 4 + sc) O[mc] = MFMA(cur.a[i], cur.v[sc], O[mc]);
      }
      u32* rp = reinterpret_cast<u32*>(red) + ((size_t)((cnt & 1) * 8 + wv) * 16) * 64 + lane;
#pragma unroll
      for (int mt = 0; mt < 2; ++mt)
#pragma unroll
        for (int r2 = 0; r2 < 8; ++r2) rp[(mt * 8 + r2) * 64] = pack2(O[mt][2 * r2], O[mt][2 * r2 + 1]);
#pragma unroll
      for (int s16 = 0; s16 < 4; ++s16) S = MFMA(cur.k[s16], cur.v[s16], S);
#pragma unroll
      for (int g4 = 0; g4 < 4; ++g4) {
        S[4 * g4 + 0] *= cur.dl[g4].x; S[4 * g4 + 1] *= cur.dl[g4].y; S[4 * g4 + 2] *= cur.dl[g4].z; S[4 * g4 + 3] *= cur.dl[g4].w;
      }
      asm volatile("s_waitcnt lgkmcnt(0)" ::: "memory");
      __builtin_amdgcn_s_barrier();
      asm volatile("" ::: "memory");
      {
        const u32* rg = reinterpret_cast<const u32*>(red) + ((size_t)((cnt & 1) * 8 + grp * WPI) * 16) * 64 + lane;
#pragma unroll
        for (int i = 0; i < NV; i += 2) {
          float sum0 = 0.f, sum1 = 0.f;
#pragma unroll
          for (int w2 = 0; w2 < WPI; ++w2) { const u32 pk = rg[((size_t)w2 * 16 + (wg * NV + i) / 2) * 64]; sum0 += bflo(pk); sum1 += bfhi(pk); }
          osum[i >> 1] = pack2(sum0, sum1);
        }
        if (!DEFER) store_o(row0);
      }
      ++cnt;
      if (ch + 1 < nch) cur = nxt;
    }
    if (DEFER) store_o(seq < 4 ? (size_t)(cg0 + nch - 1) * 64 : (size_t)PROWS + (size_t)(seq - 4) * 32);
#pragma unroll
    for (int reg = 0; reg < 16; ++reg) st_out[sbase + (size_t)crow(reg, hh) * VH] = S[reg];
  }
}

DI void gate_phase(u16* hb, const u16* proj, int ld, int zoff, const float* w, int G, float scale) {
  const int tid = opq(threadIdx.x); const int lane = tid & 63, wv = tid >> 6;
  for (int row = blockIdx.x * 8 + wv; row < MROWS; row += gridDim.x * 8) {
    u32x2* hp = reinterpret_cast<u32x2*>(hb + (size_t)row * DM);
    const u32x2* zp = reinterpret_cast<const u32x2*>(proj + (size_t)row * ld + zoff);
    float o[8][4], ss[8];
#pragma unroll
    for (int i = 0; i < 8; ++i) {
      const u32x2 pk = hp[i * 64 + lane];
      o[i][0] = bflo(pk.x); o[i][1] = bfhi(pk.x); o[i][2] = bflo(pk.y); o[i][3] = bfhi(pk.y);
      ss[i] = o[i][0] * o[i][0] + o[i][1] * o[i][1] + o[i][2] * o[i][2] + o[i][3] * o[i][3];
    }
#pragma unroll
    for (int i = 0; i < 8; ++i) ss[i] = wave_sum(ss[i]);
    if (G == 512) {
#pragma unroll
      for (int i = 0; i < 8; i += 2) { const float t = ss[i] + ss[i + 1]; ss[i] = t; ss[i + 1] = t; }
    } else if (G == 2048) {
      float t = 0.f;
#pragma unroll
      for (int i = 0; i < 8; ++i) t += ss[i];
#pragma unroll
      for (int i = 0; i < 8; ++i) ss[i] = t;
    }
    const float invG = 1.f / (float)G;
#pragma unroll
    for (int i = 0; i < 8; ++i) {
      const float r = rsqrtf(ss[i] * invG + 1e-6f) * scale;
      const int col = i * 256 + lane * 4;
      const float4 ww = *reinterpret_cast<const float4*>(w + (col & (G - 1)));
      const u32x2 zk = zp[i * 64 + lane];
      const float z0 = bflo(zk.x), z1 = bfhi(zk.x), z2 = bflo(zk.y), z3 = bfhi(zk.y);
      const float g0 = o[i][0] * r * ww.x * (z0 / (1.f + expf(-z0)));
      const float g1 = o[i][1] * r * ww.y * (z1 / (1.f + expf(-z1)));
      const float g2 = o[i][2] * r * ww.z * (z2 / (1.f + expf(-z2)));
      const float g3 = o[i][3] * r * ww.w * (z3 / (1.f + expf(-z3)));
      u32x2 ov = {pack2(g0, g1), pack2(g2, g3)};
      hp[i * 64 + lane] = ov;
    }
  }
}

constexpr size_t SZ_VTP = (size_t)4 * 8 * 256 * 4096;
constexpr size_t SZ_KS = (size_t)8 * 16 * 1088 * 128;
DI void diffprep_cache(const Params& p, char* prep, int rank, int nranks) {
  u16* VTP = reinterpret_cast<u16*>(prep);
  u16* KS = VTP + SZ_VTP;
  u16* VTS = KS + SZ_KS;
  const int tid0 = opq(threadIdx.x), half = tid0 >> 8, tid = tid0 & 255;
  for (int it = rank * 2 + half; it < 8 * 8 * 16; it += nranks * 2) {
    const int kt = it & 15, bh = it >> 4, b = bh >> 3, h = bh & 7;
    u16* dst = VTS + ((size_t)((b * 8 + h) * 256 + tid)) * 1088 + kt * 64;
    const float* src = p.cache_v + ((size_t)(b * 1024 + kt * 64) * 8 + h) * 256 + tid;
#pragma unroll
    for (int g16 = 0; g16 < 4; ++g16) {
      float v[16];
#pragma unroll
      for (int e = 0; e < 16; ++e) v[e] = src[(size_t)(g16 * 16 + e) * 2048];
      u32x4 o0 = {pack2(v[0], v[1]), pack2(v[2], v[3]), pack2(v[8], v[9]), pack2(v[10], v[11])};
      u32x4 o1 = {pack2(v[4], v[5]), pack2(v[6], v[7]), pack2(v[12], v[13]), pack2(v[14], v[15])};
      *reinterpret_cast<u32x4*>(dst + g16 * 16) = o0;
      *reinterpret_cast<u32x4*>(dst + g16 * 16 + 8) = o1;
    }
  }
  const int nchunks = 8 * 16 * 1024 * 16;
  for (int id = rank * 512 + tid0; id < nchunks; id += nranks * 512) {
    const int d8 = id & 15, rest = id >> 4, key = rest & 1023, bn = rest >> 10, b = bn >> 4, n = bn & 15;
    const float4* sp = reinterpret_cast<const float4*>(p.cache_k + ((size_t)(b * 1024 + key) * 16 + n) * 128 + d8 * 8);
    const float4 a = sp[0], c = sp[1];
    u32x4 o = {pack2(a.x, a.y), pack2(a.z, a.w), pack2(c.x, c.y), pack2(c.z, c.w)};
    *reinterpret_cast<u32x4*>(KS + ((size_t)(b * 16 + n) * 1088 + key) * 128 + d8 * 8) = o;
  }
}
DI void diffprep_phase(const Params& p, const u16* proj, char* prep, char* smem) {
  u16* VTP = reinterpret_cast<u16*>(prep);
  u16* KS = VTP + SZ_VTP;
  u16* VTS = KS + SZ_KS;
  const int tid0 = opq(threadIdx.x), half = tid0 >> 8, tid = tid0 & 255;
  u16* tl = reinterpret_cast<u16*>(smem) + half * (64 * 264);
  for (int it = blockIdx.x * 2 + half; it < 2048; it += gridDim.x * 2) {
    const int h = it & 7, c = (it >> 3) & 63, b = it >> 9;
    const u16* src = proj + (size_t)(b * 4096 + c * 64) * 8192 + 4096 + h * 256;
    __syncthreads();
#pragma unroll
    for (int i = 0; i < 8; ++i) {
      const int id = tid + 256 * i, t = id >> 5, ch = id & 31;
      *reinterpret_cast<u32x4*>(tl + t * 264 + ch * 8) = *reinterpret_cast<const u32x4*>(src + (size_t)t * 8192 + ch * 8);
    }
    __syncthreads();
    u16* dst = VTP + ((size_t)((b * 8 + h) * 256 + tid)) * 4096 + c * 64;
#pragma unroll
    for (int g16 = 0; g16 < 4; ++g16) {
      u32 pk[8];
#pragma unroll
      for (int e = 0; e < 8; ++e) {
        const int t = g16 * 16 + 2 * e;
        pk[e] = (u32)tl[t * 264 + tid] | ((u32)tl[(t + 1) * 264 + tid] << 16);
      }
      u32x4 o0 = {pk[0], pk[1], pk[4], pk[5]}, o1 = {pk[2], pk[3], pk[6], pk[7]};
      *reinterpret_cast<u32x4*>(dst + g16 * 16) = o0;
      *reinterpret_cast<u32x4*>(dst + g16 * 16 + 8) = o1;
    }
  }
  for (int it = blockIdx.x * 2 + half; it < 8 * 8; it += gridDim.x * 2) {
    const int b = it >> 3, h = it & 7;
    u16* dst = VTS + ((size_t)((b * 8 + h) * 256 + tid)) * 1088 + 16 * 64;
#pragma unroll
    for (int g16 = 0; g16 < 4; ++g16) {
      u32 pk[8];
#pragma unroll
      for (int e = 0; e < 8; ++e) {
        const int k0 = g16 * 16 + 2 * e;
        const u32 lo = k0 < 32 ? (u32)proj[(size_t)(PROWS + b * 32 + k0) * 8192 + 4096 + h * 256 + tid] : 0u;
        const u32 hi = k0 + 1 < 32 ? (u32)proj[(size_t)(PROWS + b * 32 + k0 + 1) * 8192 + 4096 + h * 256 + tid] : 0u;
        pk[e] = lo | (hi << 16);
      }
      u32x4 o0 = {pk[0], pk[1], pk[4], pk[5]}, o1 = {pk[2], pk[3], pk[6], pk[7]};
      *reinterpret_cast<u32x4*>(dst + g16 * 16) = o0;
      *reinterpret_cast<u32x4*>(dst + g16 * 16 + 8) = o1;
    }
  }
  const int nchunks = 8 * 16 * 64 * 16;
  for (int id = blockIdx.x * 512 + tid0; id < nchunks; id += gridDim.x * 512) {
    const int d8 = id & 15, rest = id >> 4, kl = rest & 63, bn = rest >> 6, b = bn >> 4, n = bn & 15;
    u32x4 o = {0u, 0u, 0u, 0u};
    if (kl < 32) o = *reinterpret_cast<const u32x4*>(proj + (size_t)(PROWS + b * 32 + kl) * 8192 + 2048 + n * 128 + d8 * 8);
    *reinterpret_cast<u32x4*>(KS + ((size_t)(b * 16 + n) * 1088 + 1024 + kl) * 128 + d8 * 8) = o;
  }
}

DI void attn_phase(const Params& p, const u16* proj, const char* prep, u16* obuf, char* smem) {
  const u16* VTP = reinterpret_cast<const u16*>(prep);
  const u16* KS = VTP + SZ_VTP;
  const u16* VTS = KS + SZ_KS;
  constexpr int BUFE = 2 * 64 * 136 + 256 * 72;
  u16* lds = reinterpret_cast<u16*>(smem);
  float* Ot = reinterpret_cast<float*>(smem);
  const int tid = opq(threadIdx.x), lane = tid & 63, wv = __builtin_amdgcn_readfirstlane(tid >> 6), l31 = lane & 31, hh = lane >> 5;
  const int qt = wv & 1, jh = (wv >> 1) & 1, vh = wv >> 2;
  const int G = gridDim.x;
  bool xcdmap = (G == 256);
  int xx = (int)blockIdx.x & 7, yy = (int)blockIdx.x >> 3;
  if (xcdmap) {
    const unsigned* bar = reinterpret_cast<const unsigned*>(p.ws + WS_BAR);
    bool even = true;
#pragma unroll
    for (int jx = 0; jx < 8; ++jx) even = even && (bar[256 + 64 * jx] == 32u);
    if (even) {
      const unsigned sl = reinterpret_cast<volatile unsigned*>(smem + LDS_BYTES - 16)[2];
      xx = (int)(sl >> 16) & 7; yy = (int)(sl & 31u);
    }
  }
  xx = __builtin_amdgcn_readfirstlane(xx); yy = __builtin_amdgcn_readfirstlane(yy);
  const int nrounds = xcdmap ? 9 : (2048 + 64 + G - 1) / G;
  for (int r = 0; r < nrounds; ++r) {
    int i;
    if (xcdmap) {
      const int x = xx, y = yy;
      if (r < 8) { const int bh = x * 4 + (r >> 1), c = (r & 1) ? y : 63 - y; i = ((63 - c) << 5) | bh; }
      else { i = (x * 32 + y) < 64 ? 2048 + (x * 32 + y) : 1 << 30; }
    } else {
      i = r * G + (int)blockIdx.x;
    }
    if (i >= 2048 + 64) continue;
    int b, h, nt, nkeys, nq; size_t qrow0, kstride, khs, vtstride; const u16* kbase; const u16* vtbase;
    if (i < 2048) {
      const int c = 63 - (i >> 5), bh = i & 31; b = bh >> 3; h = bh & 7; nt = c + 1; nkeys = nt * 64; nq = 64;
      qrow0 = (size_t)b * 4096 + c * 64;
      kbase = proj + (size_t)(b * 4096) * 8192 + 2048 + (2 * h) * 128; kstride = 8192; khs = 128;
      vtbase = VTP + (size_t)((b * 8 + h) * 256) * 4096; vtstride = 4096;
    } else {
      const int bh = i - 2048; b = bh >> 3; h = bh & 7; nt = 17; nkeys = 1056; nq = 32;
      qrow0 = (size_t)PROWS + b * 32;
      kbase = KS + (size_t)((b * 16 + 2 * h) * 1088) * 128; kstride = 128; khs = (size_t)1088 * 128;
      vtbase = VTS + (size_t)((b * 8 + h) * 256) * 1088; vtstride = 1088;
    }
    bf16x8 Qf[8];
    {
      const size_t qrow = qrow0 + ((qt * 32 < nq) ? qt * 32 : 0) + l31;
      const u16* qp = proj + qrow * 8192 + (2 * h + jh) * 128 + hh * 8;
#pragma unroll
      for (int s = 0; s < 8; ++s) Qf[s] = ld16(qp + s * 16);
#pragma unroll
      for (int s = 0; s < 8; ++s) asm volatile("" : "+v"(Qf[s]));
    }
    u32x4 kr[4], vr[4];
    auto gload = [&](int kt) {
#pragma unroll
      for (int ii = 0; ii < 4; ++ii) {
        const int id = tid + 512 * ii;
        const int jl = id >> 10, key = (id >> 4) & 63, ch = id & 15;
        kr[ii] = *reinterpret_cast<const u32x4*>(kbase + jl * khs + (size_t)(kt * 64 + key) * kstride + ch * 8);
        const int vd = id >> 3, cv = id & 7;
        vr[ii] = *reinterpret_cast<const u32x4*>(vtbase + (size_t)vd * vtstride + kt * 64 + cv * 8);
      }
    };
    auto sstore = [&](int buf) {
      u16* Ks = lds + buf * BUFE; u16* Vt = Ks + 2 * 64 * 136;
#pragma unroll
      for (int ii = 0; ii < 4; ++ii) {
        const int id = tid + 512 * ii;
        const int jl = id >> 10, key = (id >> 4) & 63, ch = id & 15;
        *reinterpret_cast<u32x4*>(Ks + (jl * 64 + key) * 136 + ch * 8) = kr[ii];
        const int vd = id >> 3, cv = id & 7;
        *reinterpret_cast<u32x4*>(Vt + vd * 72 + cv * 8) = vr[ii];
      }
    };
    float m = -1e30f, l = 0.f;
    f32x16 O[4];
#pragma unroll
    for (int vt = 0; vt < 4; ++vt) O[vt] = zero16();
#define ATT_BAR() do { asm volatile("s_waitcnt lgkmcnt(0)" ::: "memory"); __builtin_amdgcn_s_barrier(); asm volatile("" ::: "memory"); } while (0)
    gload(0);
    __syncthreads();
    sstore(0);
    __syncthreads();
    for (int kt = 0; kt < nt; ++kt) {
      if (kt + 1 < nt) gload(kt + 1);
      const u16* Ks = lds + (kt & 1) * BUFE; const u16* Vt = Ks + 2 * 64 * 136;
      f32x16 st[2];
      __builtin_amdgcn_s_setprio(1);
#pragma unroll
      for (int kti = 0; kti < 2; ++kti) {
        st[kti] = zero16();
#pragma unroll
        for (int s = 0; s < 8; ++s) {
          const bf16x8 a = ld16(Ks + (jh * 64 + kti * 32 + l31) * 136 + s * 16 + hh * 8);
          st[kti] = MFMA(a, Qf[s], st[kti]);
        }
      }
      __builtin_amdgcn_s_setprio(0);
      constexpr float SC = 0.08838834764831845f * 1.4426950408889634f;
      if ((kt + 1) * 64 > nkeys) {
#pragma unroll
        for (int kti = 0; kti < 2; ++kti)
#pragma unroll
          for (int reg = 0; reg < 16; ++reg)
            if (kt * 64 + kti * 32 + crow(reg, hh) >= nkeys) st[kti][reg] = -1e30f;
      }
      float mx = -1e30f;
#pragma unroll
      for (int kti = 0; kti < 2; ++kti)
#pragma unroll
        for (int reg = 0; reg < 16; ++reg) mx = fmaxf(mx, st[kti][reg]);
      mx = fmaxf(mx, __shfl_xor(mx, 32)) * SC;
      const float mn = fmaxf(m, mx);
      float rs = 0.f;
#pragma unroll
      for (int kti = 0; kti < 2; ++kti)
#pragma unroll
        for (int reg = 0; reg < 16; ++reg) {
          const float pv = __builtin_amdgcn_exp2f(st[kti][reg] * SC - mn);
          st[kti][reg] = pv; rs += pv;
        }
      rs += __shfl_xor(rs, 32);
      if (__any(mn != m)) {
        const float alpha = __builtin_amdgcn_exp2f(m - mn);
        l *= alpha;
#pragma unroll
        for (int vt = 0; vt < 4; ++vt)
#pragma unroll
          for (int reg = 0; reg < 16; ++reg) O[vt][reg] *= alpha;
      }
      l += rs; m = mn;
      __builtin_amdgcn_s_setprio(1);
#pragma unroll
      for (int kti = 0; kti < 2; ++kti) {
        {
          const bf16x8 pf = packacc<0>(st[kti]);
#pragma unroll
          for (int vt = 0; vt < 4; ++vt) {
            O[vt] = MFMA(ld16(Vt + ((vh * 4 + vt) * 32 + l31) * 72 + kti * 32 + 8 * hh), pf, O[vt]);
          }
        }
        {
          const bf16x8 pf = packacc<1>(st[kti]);
#pragma unroll
          for (int vt = 0; vt < 4; ++vt) {
            O[vt] = MFMA(ld16(Vt + ((vh * 4 + vt) * 32 + l31) * 72 + kti * 32 + 16 + 8 * hh), pf, O[vt]);
          }
        }
      }
      __builtin_amdgcn_s_setprio(0);
      if (kt + 1 < nt) sstore((kt + 1) & 1);
      ATT_BAR();
    }
#undef ATT_BAR
    const float inv = 1.f / l;
    float lam;
    {
      const float* lp = p.diff_lambda;
      float s1 = lp[lane] * lp[128 + lane] + lp[64 + lane] * lp[192 + lane];
      float s2 = lp[256 + lane] * lp[384 + lane] + lp[320 + lane] * lp[448 + lane];
      s1 = wave_sum(s1); s2 = wave_sum(s2);
      lam = expf(s1) - expf(s2) + LAM_INIT;
    }
    if (jh == 1) {
#pragma unroll
      for (int vt = 0; vt < 4; ++vt)
#pragma unroll
        for (int reg = 0; reg < 16; ++reg) Ot[(qt * 32 + l31) * 257 + (vh * 4 + vt) * 32 + crow(reg, hh)] = lam * O[vt][reg] * inv;
    }
    __syncthreads();
    if (jh == 0) {
#pragma unroll
      for (int vt = 0; vt < 4; ++vt)
#pragma unroll
        for (int reg = 0; reg < 16; ++reg) {
          const int idx = (qt * 32 + l31) * 257 + (vh * 4 + vt) * 32 + crow(reg, hh);
          Ot[idx] = O[vt][reg] * inv - Ot[idx];
        }
    }
    __syncthreads();
    {
#pragma unroll 1
      for (int rr = 0; rr < 8; ++rr) {
        const int q = wv * 8 + rr;
        const float a0 = Ot[q * 257 + lane], a1 = Ot[q * 257 + 64 + lane], a2 = Ot[q * 257 + 128 + lane], a3 = Ot[q * 257 + 192 + lane];
        float ss = wave_sum(a0 * a0 + a1 * a1 + a2 * a2 + a3 * a3);
        if (lane == 0) Ot[q * 257 + 256] = rsqrtf(ss * (1.f / 256.f) + 1e-6f) * (1.f - LAM_INIT);
      }
    }
    __syncthreads();
    {
      u32 zk[16];
      const int te = opq(tid);
#pragma unroll
      for (int ii = 0; ii < 16; ++ii) {
        const int id = te + 512 * ii, q = id >> 7, vd = (id & 127) * 2;
        zk[ii] = *reinterpret_cast<const u32*>(proj + (qrow0 + (q < nq ? q : 0)) * 8192 + 6144 + h * 256 + vd);
      }
      const int vd0 = (te & 127) * 2;
      const float w0 = p.diff_subln_w[vd0], w1 = p.diff_subln_w[vd0 + 1];
#pragma unroll
      for (int ii = 0; ii < 16; ++ii) {
        const int id = te + 512 * ii, q = id >> 7, vd = (id & 127) * 2;
        if (q < nq) {
          const float r = Ot[q * 257 + 256];
          const float z0 = bflo(zk[ii]), z1 = bfhi(zk[ii]);
          const float g0 = Ot[q * 257 + vd] * r * w0 * (z0 / (1.f + __builtin_amdgcn_exp2f(-z0 * 1.4426950408889634f)));
          const float g1 = Ot[q * 257 + vd + 1] * r * w1 * (z1 / (1.f + __builtin_amdgcn_exp2f(-z1 * 1.4426950408889634f)));
          *reinterpret_cast<u32*>(obuf + (qrow0 + q) * DM + h * 256 + vd) = pack2(g0, g1);
        }
      }
    }
  }
}

#define XB_TMO      128
#define XB_XCNT(j)  (256  + 64 * (j))
#define XB_XSUB(j)  (1280 + 64 * (j))
#define XB_XGEN(j)  (2304 + 64 * (j))
#define XB_TOP      3328
#define XB_TOPGEN   3392
#define XCD_BAR_WORDS 3456
#define XB_SPIN_CAP (1u << 18)
DI unsigned xb_ld(unsigned* p) { return __hip_atomic_load(p, __ATOMIC_RELAXED, __HIP_MEMORY_SCOPE_AGENT); }
DI unsigned xb_add(unsigned* p, unsigned v) { return __hip_atomic_fetch_add(p, v, __ATOMIC_RELAXED, __HIP_MEMORY_SCOPE_AGENT); }
DI unsigned xb_xcc_id() { return (unsigned)__builtin_amdgcn_s_getreg((3 << 11) | 20) & 0xFu; }
#define XB_SPIN(cond, bar) do { unsigned _sp = 0; while (cond) { __builtin_amdgcn_s_sleep(1); \
    if ((++_sp & 255u) == 0u) { if (xb_ld(&(bar)[XB_TMO])) break; if (_sp > XB_SPIN_CAP) { atomicAdd(&(bar)[XB_TMO], 1u); break; } } } } while (0)
struct XcdBarrier { unsigned* bar; unsigned x; volatile LAS unsigned* st; };
DI XcdBarrier xcd_barrier_post(unsigned* bar, volatile LAS unsigned* st) {
  XcdBarrier b; b.bar = bar; b.x = xb_xcc_id(); b.st = st;
  if (threadIdx.x == 0) (void)xb_add(&bar[XB_XCNT(b.x)], 1u);
  return b;
}
DI void xcd_barrier_complete(unsigned* bar, unsigned x, unsigned& nloc, unsigned& nx) {
  const unsigned G = gridDim.x * gridDim.y * gridDim.z;
  unsigned sum, cnt, mine, sp = 0u;
  for (;;) {
    sum = 0u; cnt = 0u; mine = 0u;
#pragma unroll
    for (unsigned j = 0; j < 16; ++j) { const unsigned c = xb_ld(&bar[XB_XCNT(j)]); sum += c; cnt += (c > 0u) ? 1u : 0u; mine = (j == x) ? c : mine; }
    if (sum == G) break;
    __builtin_amdgcn_s_sleep(1);
    if ((++sp & 255u) == 0u) { if (xb_ld(&bar[XB_TMO])) break; if (sp > XB_SPIN_CAP) { atomicAdd(&bar[XB_TMO], 1u); break; } }
  }
  nloc = mine > 0u ? mine : 1u; nx = cnt > 0u ? cnt : 1u;
}
DI void xcd_barrier(const XcdBarrier& b) {
  asm volatile("s_waitcnt vmcnt(0)" ::: "memory");
  __syncthreads();
  if (threadIdx.x == 0) {
    unsigned* bar = b.bar;
    __builtin_amdgcn_s_waitcnt(0);
    unsigned nloc = b.st[0], nx = b.st[1];
    if (nloc == 0u) { xcd_barrier_complete(bar, b.x, nloc, nx); b.st[0] = nloc; b.st[1] = nx; }
    const unsigned old = xb_add(&bar[XB_XSUB(b.x)], 1u);
    const unsigned gen = old / nloc;
    if (old + 1u == (gen + 1u) * nloc) {
      __builtin_amdgcn_fence(__ATOMIC_RELEASE, "agent");
      asm volatile("s_waitcnt vmcnt(0)" ::: "memory");
      const unsigned og = xb_add(&bar[XB_TOP], 1u);
      const unsigned tg = og / nx;
      if (og + 1u == (tg + 1u) * nx) xb_add(&bar[XB_TOPGEN], 1u);
      else XB_SPIN(xb_ld(&bar[XB_TOPGEN]) == tg, bar);
      __builtin_amdgcn_fence(__ATOMIC_ACQUIRE, "agent");
      xb_add(&bar[XB_XGEN(b.x)], 1u);
      asm volatile("s_waitcnt vmcnt(0)" ::: "memory");
    } else {
      XB_SPIN(xb_ld(&bar[XB_XGEN(b.x)]) == gen, bar);
      __builtin_amdgcn_fence(__ATOMIC_ACQUIRE, "agent");
      asm volatile("s_waitcnt vmcnt(0)" ::: "memory");
    }
  }
  __syncthreads();
}

typedef const __attribute__((address_space(4))) Params* KPtr;
#if defined(__HIP_DEVICE_COMPILE__)
DI Params KP() { KPtr q = (KPtr)__builtin_amdgcn_kernarg_segment_ptr(); asm volatile("" : "+s"(q)); return *q; }
#else
DI Params KP() { return Params{}; }
#endif

DI void gsync(const Params& p, char* smem) {
  unsigned long long ba = reinterpret_cast<unsigned long long>(p.ws + WS_BAR);
  asm volatile("" : "+s"(ba));
  XcdBarrier b; b.bar = reinterpret_cast<unsigned*>(ba); b.x = xb_xcc_id();
  b.st = reinterpret_cast<volatile LAS unsigned*>((LAS unsigned char*)smem + LDS_BYTES - 16);
  xcd_barrier(b);
}

template <int LAYER>
DI void conv_layer(const Params& p, u16* WIN, u16* wout, int rank, int nranks) {
  constexpr int kind = LAYER % 3, j = LAYER / 3;
  if (kind == 0) {
    conv_job(p.gla_w_in + (size_t)j * 2048 * 6144, 6144, 6144, WIN, 0, rank, nranks);
    conv_job(p.gla_w_a1 + (size_t)j * 2048 * 16, 16, 16, WIN, 6144, rank, nranks);
    for (int id = rank * 512 + opq(threadIdx.x); id < 240 * 256; id += nranks * 512) {
      u32x4 z = {0u, 0u, 0u, 0u};
      reinterpret_cast<u32x4*>(WIN + (size_t)6160 * 2048)[id] = z;
    }
    conv_job(p.gla_w_out + (size_t)j * 2048 * 2048, 2048, 2048, wout, 0, rank, nranks);
  } else if (kind == 1) {
    conv_job(p.hgrn_w_in, 8192, 8192, WIN, 0, rank, nranks);
    conv_job(p.hgrn_w_out, 2048, 2048, wout, 0, rank, nranks);
  } else {
    conv_job(p.diff_w_in, 8192, 8192, WIN, 0, rank, nranks);
    conv_job(p.diff_w_out, 2048, 2048, wout, 0, rank, nranks);
  }
}

template <int LAYER>
DI void do_layer(char* smem, cg::grid_group& grid) {
  const Params p = KP();
  constexpr int layer = LAYER, kind = LAYER % 3, j = LAYER / 3;
  u16* WIN = reinterpret_cast<u16*>(p.ws + WS_WIN);
  u16* WOUT = reinterpret_cast<u16*>(p.ws + ((layer & 1) ? WS_WOUT1 : WS_WOUT));
  u16* WOUT_NEXT = reinterpret_cast<u16*>(p.ws + ((layer & 1) ? WS_WOUT : WS_WOUT1));
  u16* HB = reinterpret_cast<u16*>(p.ws + WS_H);
  u16* PROJ = reinterpret_cast<u16*>(p.ws + WS_PROJ);
  char* PREP_WS = p.ws + WS_PREP;
  char* PREP_OUT = reinterpret_cast<char*>(p.out + OFF_KP);
  if (layer == 0) conv_layer<0>(KP(), WIN, WOUT, blockIdx.x, gridDim.x);
  float* RS = reinterpret_cast<float*>(p.ws + WS_RS);
  u16* XW = reinterpret_cast<u16*>(p.ws + WS_XW);
  if (layer == 0) {
    norm_phase(p.x_prompt, p.x_sample, p.norm_w, HB);
    for (int i = blockIdx.x * 512 + opq(threadIdx.x); i < 4 * MROWS; i += gridDim.x * 512) RS[i] = 0.f;
    grid.sync();
    (void)xcd_barrier_post(reinterpret_cast<unsigned*>(p.ws + WS_BAR), reinterpret_cast<volatile LAS unsigned*>((LAS unsigned char*)smem + LDS_BYTES - 16));
    if (threadIdx.x == 0) {
      const unsigned x = xb_xcc_id();
      const unsigned y = xb_add(reinterpret_cast<unsigned*>(p.ws + WS_BAR) + 8 * x, 1u);
      reinterpret_cast<volatile unsigned*>(smem + LDS_BYTES - 16)[2] = (x << 16) | (y & 0xffffu);
    }
  }
  {
    pg8::EpiProj E; E.O = PROJ; E.ldc = kind == 0 ? GLA_LD : 8192; E.out = p.out; E.mode = kind == 2 ? 1 : 0;
    E.rs = layer == 0 ? nullptr : RS + (layer - 1) * MROWS;
    gemm8(smem, layer == 0 ? HB : XW, WIN, kind == 0 ? GLA_LD : 8192, E);
  }
  gsync(KP(), smem);
  if (kind == 0) {
    prep_phase<0>(KP(), layer, j, PROJ, PREP_WS, smem);
    gsync(KP(), smem);
    seq_phase<0>(KP(), j, PREP_WS, HB, smem);
  } else if (kind == 1) {
    prep_phase<1>(KP(), layer, j, PROJ, PREP_OUT, smem);
    gsync(KP(), smem);
    seq_phase<1>(KP(), j, PREP_OUT, HB, smem);
    if ((int)blockIdx.x >= 128 && gridDim.x > 128) diffprep_cache(KP(), PREP_WS, (int)blockIdx.x - 128, (int)gridDim.x - 128);
    else if (gridDim.x <= 128) diffprep_cache(KP(), PREP_WS, blockIdx.x, gridDim.x);
  } else {
    diffprep_phase(KP(), PROJ, PREP_WS, smem);
    gsync(KP(), smem);
    attn_phase(KP(), PROJ, PREP_WS, HB, smem);
  }
  gsync(KP(), smem);
  if (kind == 0) gate_phase(HB, PROJ, GLA_LD, 4096, p.gla_norm_w + j * 512, 512, 1.f);
  else if (kind == 1) gate_phase(HB, PROJ, 8192, 6144, p.hgrn_norm_w, 2048, 1.f);
  if (kind != 2) gsync(KP(), smem);
  {
    pg8::EpiRes E; E.xp = p.x_prompt; E.xs = p.x_sample; E.out = p.out; E.layer = layer;
    E.wn = p.norm_w + (layer < 3 ? (layer + 1) * DM : 0); E.xw = layer < 3 ? XW : nullptr; E.rs = RS + layer * MROWS;
    gemm8(smem, HB, WOUT, 2048, E);
    if (layer < 3) {
      const int nwg = (MROWS / 256) * (2048 / 256), G = gridDim.x, R = nwg % G;
      if ((int)blockIdx.x >= R) conv_layer<(LAYER + 1) % 4>(KP(), WIN, WOUT_NEXT, (int)blockIdx.x - R, G - R);
    }
  }
  gsync(KP(), smem);
}

__global__ void __launch_bounds__(512) mega(Params p) {
  extern __shared__ __attribute__((aligned(16))) char smem[];
  cg::grid_group grid = cg::this_grid();
  {
    unsigned* bar = reinterpret_cast<unsigned*>(p.ws + WS_BAR);
    if (blockIdx.x == 0) for (int i = threadIdx.x; i < XCD_BAR_WORDS; i += 512) bar[i] = 0u;
    if (threadIdx.x < 4) reinterpret_cast<volatile unsigned*>(smem + LDS_BYTES - 16)[threadIdx.x] = 0u;
    __syncthreads();
  }
  do_layer<0>(smem, grid);
  do_layer<1>(smem, grid);
  do_layer<2>(smem, grid);
  do_layer<3>(smem, grid);
  final_norm_phase(p.out, p.final_norm_w, reinterpret_cast<const float*>(p.ws + WS_RS) + 3 * MROWS);
}

extern "C" void kernel_launch(void* const* d_in, const int* in_sizes, int n_in, void* d_out, int out_size, void* d_ws, size_t ws_size,
                              hipStream_t stream) {
  Params p{};
  p.x_prompt = (const float*)d_in[0]; p.x_sample = (const float*)d_in[1]; p.state_gla = (const float*)d_in[2]; p.state_hgrn = (const float*)d_in[3];
  p.cache_k = (const float*)d_in[4]; p.cache_v = (const float*)d_in[5]; p.norm_w = (const float*)d_in[6]; p.final_norm_w = (const float*)d_in[7];
  p.gla_w_in = (const float*)d_in[8]; p.gla_w_a1 = (const float*)d_in[9]; p.gla_w_a2 = (const float*)d_in[10]; p.gla_b_a = (const float*)d_in[11];
  p.gla_norm_w = (const float*)d_in[12]; p.gla_w_out = (const float*)d_in[13];
  p.hgrn_w_in = (const float*)d_in[14]; p.hgrn_lb = (const float*)d_in[15]; p.hgrn_norm_w = (const float*)d_in[16]; p.hgrn_w_out = (const float*)d_in[17];
  p.diff_w_in = (const float*)d_in[18]; p.diff_lambda = (const float*)d_in[19]; p.diff_subln_w = (const float*)d_in[20]; p.diff_w_out = (const float*)d_in[21];
  p.out = (float*)d_out; p.ws = (char*)d_ws;
  static int grid_blocks = 0;
  if (!grid_blocks) {
    int dev = 0, cus = 0, per_cu = 0;
    (void)hipGetDevice(&dev);
    (void)hipFuncSetAttribute((const void*)mega, hipFuncAttributeMaxDynamicSharedMemorySize, (int)LDS_BYTES);
    (void)hipDeviceGetAttribute(&cus, hipDeviceAttributeMultiprocessorCount, dev);
    (void)hipOccupancyMaxActiveBlocksPerMultiprocessor(&per_cu, mega, 512, LDS_BYTES);
    if (per_cu < 1) per_cu = 1;
    if (per_cu > 1) per_cu = 1;
    grid_blocks = cus * per_cu;
  }
  void* args[] = {&p};
  hipError_t e = hipLaunchCooperativeKernel((void*)mega, dim3(grid_blocks), dim3(512), args, LDS_BYTES, stream);
  if (e != hipSuccess) fprintf(stderr, "cooperative launch failed: %s (grid %d)\n", hipGetErrorString(e), grid_blocks);
}
```

```cpp
#include <hip/hip_runtime.h>
#include <hip/hip_cooperative_groups.h>
#include <cstdio>
namespace cg = cooperative_groups;

typedef unsigned short u16;
typedef unsigned int u32;
using bf16x8 = __attribute__((ext_vector_type(8))) short;
using f32x16 = __attribute__((ext_vector_type(16))) float;
using f32x4 = __attribute__((ext_vector_type(4))) float;
using u32x4 = __attribute__((ext_vector_type(4))) unsigned;
using u32x2 = __attribute__((ext_vector_type(2))) unsigned;

#define DI __device__ __forceinline__
#define MFMA(a, b, c) __builtin_amdgcn_mfma_f32_32x32x16_bf16((a), (b), (c), 0, 0, 0)
#define LAS __attribute__((address_space(3)))

constexpr int MROWS = 16640;
constexpr int PROWS = 16384;
constexpr int DM = 2048;
constexpr size_t OFF_GSP = 34078720;
constexpr size_t OFF_GSS = 38273024;
constexpr size_t OFF_HSP = 46661632;
constexpr size_t OFF_HSS = 47710208;
constexpr size_t OFF_KP = 49807360;
constexpr size_t OFF_VP = 83361792;
constexpr size_t OFF_KS = 116916224;
constexpr size_t OFF_VS = 117440512;
constexpr size_t WS_WIN = 0;
constexpr size_t WS_WOUT = 33554432;
constexpr size_t WS_H = 41943040;
constexpr size_t WS_PROJ = 110100480;
constexpr size_t WS_PREP = 382730240;
constexpr size_t WS_XW = 530874368;
constexpr size_t WS_BAR = 599031808;
constexpr size_t WS_RS = 599048192;
constexpr size_t WS_WOUT1 = 599314432;
constexpr size_t LDS_BYTES = 147456;
constexpr float LAM_INIT = 0.47071302f;
constexpr int GLA_LD = 6400;

struct Params {
  const float* x_prompt; const float* x_sample; const float* state_gla; const float* state_hgrn;
  const float* cache_k; const float* cache_v; const float* norm_w; const float* final_norm_w;
  const float* gla_w_in; const float* gla_w_a1; const float* gla_w_a2; const float* gla_b_a;
  const float* gla_norm_w; const float* gla_w_out;
  const float* hgrn_w_in; const float* hgrn_lb; const float* hgrn_norm_w; const float* hgrn_w_out;
  const float* diff_w_in; const float* diff_lambda; const float* diff_subln_w; const float* diff_w_out;
  float* out; char* ws;
};

typedef __bf16 bf16v2 __attribute__((ext_vector_type(2)));
typedef float f32v2 __attribute__((ext_vector_type(2)));
DI u32 pack2(float a, float b) { f32v2 v = {a, b}; return __builtin_bit_cast(u32, __builtin_convertvector(v, bf16v2)); }
DI u16 f2bf(float x) { return (u16)(pack2(x, 0.f) & 0xffffu); }
DI float bf2f(u16 b) { return __uint_as_float(((u32)b) << 16); }
DI float bflo(u32 p) { return __uint_as_float(p << 16); }
DI float bfhi(u32 p) { return __uint_as_float(p & 0xffff0000u); }
DI bf16x8 ld16(const u16* p) { return *reinterpret_cast<const bf16x8*>(p); }
DI bf16x8 ld8x2(const u16* p0, const u16* p1) {
  u32x2 a = *reinterpret_cast<const u32x2*>(p0); u32x2 b = *reinterpret_cast<const u32x2*>(p1);
  u32x4 r = {a.x, a.y, b.x, b.y}; return __builtin_bit_cast(bf16x8, r);
}
DI int opq(int x) { asm volatile("" : "+v"(x)); return x; }
DI int crow(int reg, int hh) { return (reg & 3) + 8 * (reg >> 2) + 4 * hh; }
template <int S> DI bf16x8 packacc(const f32x16& x) {
  u32x4 r = {pack2(x[8 * S], x[8 * S + 1]), pack2(x[8 * S + 2], x[8 * S + 3]), pack2(x[8 * S + 4], x[8 * S + 5]), pack2(x[8 * S + 6], x[8 * S + 7])};
  return __builtin_bit_cast(bf16x8, r);
}
DI float wave_sum(float v) {
#pragma unroll
  for (int o = 32; o > 0; o >>= 1) v += __shfl_xor(v, o);
  return v;
}
DI f32x16 zero16() { f32x16 z;
#pragma unroll
  for (int i = 0; i < 16; ++i) z[i] = 0.f;
  return z; }

DI void conv_job(const float* W, int ldw, int ncols, u16* Wt, int drow0, int rank, int nranks) {
  const int tid = opq(threadIdx.x), lane = tid & 63, wv = tid >> 6;
  const int ntn = (ncols + 63) >> 6;
  const int ntiles = 64 * ntn;
  for (int tile = rank * 8 + wv; tile < ntiles; tile += nranks * 8) {
    const int tn = tile % ntn, tk = tile / ntn;
    const int n = tn * 64 + lane, k0 = tk * 32;
    if (n < ncols) {
      const float* src = W + (size_t)k0 * ldw + n;
      float v[32];
#pragma unroll
      for (int i = 0; i < 32; ++i) v[i] = __builtin_nontemporal_load(src + (size_t)i * ldw);
      u32x4* dst = reinterpret_cast<u32x4*>(Wt + (size_t)(drow0 + n) * 2048 + k0);
#pragma unroll
      for (int i = 0; i < 4; ++i) {
        u32x4 o = {pack2(v[8 * i], v[8 * i + 1]), pack2(v[8 * i + 2], v[8 * i + 3]), pack2(v[8 * i + 4], v[8 * i + 5]), pack2(v[8 * i + 6], v[8 * i + 7])};
        dst[i] = o;
      }
    }
  }
}

DI void norm_phase(const float* xp, const float* xs, const float* w, u16* h) {
  const int tid = opq(threadIdx.x); const int lane = tid & 63, wv = tid >> 6;
  for (int row = blockIdx.x * 8 + wv; row < MROWS; row += gridDim.x * 8) {
    const float* src = row < PROWS ? xp + (size_t)row * DM : xs + (size_t)(row - PROWS) * DM;
    float4 v[8]; float ss = 0.f;
#pragma unroll
    for (int i = 0; i < 8; ++i) { v[i] = reinterpret_cast<const float4*>(src)[i * 64 + lane]; ss += v[i].x * v[i].x + v[i].y * v[i].y + v[i].z * v[i].z + v[i].w * v[i].w; }
    ss = wave_sum(ss);
    const float r = rsqrtf(ss * (1.f / 2048.f) + 1e-6f);
    u32x2* dst = reinterpret_cast<u32x2*>(h + (size_t)row * DM);
#pragma unroll
    for (int i = 0; i < 8; ++i) {
      const float4 ww = reinterpret_cast<const float4*>(w)[i * 64 + lane];
      u32x2 o = {pack2(v[i].x * r * ww.x, v[i].y * r * ww.y), pack2(v[i].z * r * ww.z, v[i].w * r * ww.w)};
      dst[i * 64 + lane] = o;
    }
  }
}

DI void final_norm_phase(float* y, const float* w, const float* rs) {
  const int tid = opq(threadIdx.x); const int lane = tid & 63, wv = tid >> 6;
  for (int row = blockIdx.x * 8 + wv; row < MROWS; row += gridDim.x * 8) {
    float4* src = reinterpret_cast<float4*>(y + (size_t)row * DM);
    const float r = rsqrtf(rs[row] * (1.f / 2048.f) + 1e-6f);
#pragma unroll
    for (int i = 0; i < 8; ++i) {
      const float4 v = src[i * 64 + lane];
      const float4 ww = reinterpret_cast<const float4*>(w)[i * 64 + lane];
      f32x4 o = {v.x * r * ww.x, v.y * r * ww.y, v.z * r * ww.z, v.w * r * ww.w};
      __builtin_nontemporal_store(o, reinterpret_cast<f32x4*>(src) + i * 64 + lane);
    }
  }
}

namespace pg8 {
constexpr int BM = 256, BK = 64, HALF = 128, HTB = HALF * BK * 2, NXCD = 8, WGM = 8;
DI int lds_byte(int r, int c) { const int st = (r >> 4) * 2 + (c >> 5), rr = r & 15, cc = c & 31, ob = rr * 64 + cc * 2; return st * 1024 + (ob ^ (((ob >> 9) & 1) << 5)); }
DI void stage_rc(int b, int& R, int& C) { const int st = b / 1024, sb = b % 1024, swz = sb ^ (((sb >> 9) & 1) << 5); R = (st >> 1) * 16 + swz / 64; C = (st & 1) * 32 + (swz % 64) / 2; }
DI int perm32(int rho) { const int n = rho >> 4, i = rho & 15; return 8 * (i >> 2) + 4 * n + (i & 3); }
struct Unit { int pm, pn; };
struct Gemm { const u16* A; const u16* Bt; int M, N, K; };
struct StaticOrder {
  int nM, nN, nwg, G, c;
  DI void init(int M, int N, int G_, int c_) { nM = M / BM; nN = N / BM; nwg = nM * nN; G = G_; c = c_; }
  DI bool next(int i, Unit& u) const {
    const long L = (long)i * G + c; if (L >= nwg) return false;
    int wgid = (int)L; { const int q = nwg / NXCD, r = nwg % NXCD, xcd = wgid % NXCD, off = wgid / NXCD; wgid = (xcd < r ? xcd * (q + 1) : r * (q + 1) + (xcd - r) * q) + off; }
    const int nig = WGM * nN, gid = wgid / nig, fm = gid * WGM, gsz = (nM - fm) < WGM ? (nM - fm) : WGM;
    u.pm = fm + ((wgid % nig) % gsz); u.pn = (wgid % nig) / gsz; return true;
  }
};

template <class Epi>
DI void gemm_phase(LAS unsigned char* lds, const Gemm g, const StaticOrder& S, const Epi& E) {
  const int tid = opq(threadIdx.x), wid = __builtin_amdgcn_readfirstlane(tid >> 6), lane = tid & 63, wr = wid >> 2, wc = wid & 3, fr = lane & 15, fq = lane >> 4;
  const int K = g.K, nt = K / BK;
  unsigned voffA[2], voffB[2];
#pragma unroll
  for (int i = 0; i < 2; ++i) { int R, C; stage_rc(tid * 16 + i * 8192, R, C); const int Rb = Epi::PERM ? ((R & ~31) + perm32(R & 31)) : R;
    voffA[i] = (unsigned)(R * K + C) * 2u; voffB[i] = (unsigned)(Rb * K + C) * 2u; }
  const size_t kstep = (size_t)(BK * 2);
  const size_t hstep = (size_t)HALF * K * 2;
  const size_t tstep = 2 * hstep;
  const unsigned ldsw = (unsigned)wid * 1024u;
  const int aoff = lds_byte(wr * 64 + fr, fq * 8), boff = lds_byte(wc * 32 + fr, fq * 8);
#define PG8_SA(b, h) (((b) * 2 + (h)) * HTB)
#define PG8_SB(b, h) ((4 + (b) * 2 + (h)) * HTB)
#define PG8_STAGE(bufoff, gbase, voff) do { _Pragma("unroll") for (int _i = 0; _i < 2; ++_i) \
    __builtin_amdgcn_global_load_lds((const unsigned*)((const char*)(gbase) + (voff)[_i]), (LAS unsigned*)(lds + (bufoff) + ldsw + _i * 8192), 16, 0, 0); } while (0)
#define PG8_LDA(dst, b, h) do { _Pragma("unroll") for (int m = 0; m < 4; ++m) _Pragma("unroll") for (int k = 0; k < 2; ++k) dst[m][k] = *(const LAS bf16x8*)(lds + PG8_SA(b, h) + aoff + m * 2048 + k * 1024); } while (0)
#define PG8_LDB(dst, b, h) do { _Pragma("unroll") for (int n = 0; n < 2; ++n) _Pragma("unroll") for (int k = 0; k < 2; ++k) dst[n][k] = *(const LAS bf16x8*)(lds + PG8_SB(b, h) + boff + n * 2048 + k * 1024); } while (0)
#define PG8_MMA(ai, bj, At, Bt) do { __builtin_amdgcn_s_setprio(1); _Pragma("unroll") for (int m = 0; m < 4; ++m) _Pragma("unroll") for (int n = 0; n < 2; ++n) _Pragma("unroll") for (int k = 0; k < 2; ++k) \
    acc[ai][bj][m][n] = __builtin_amdgcn_mfma_f32_16x16x32_bf16(Bt[n][k], At[m][k], acc[ai][bj][m][n], 0, 0, 0); __builtin_amdgcn_s_setprio(0); } while (0)
#define PG8_WAIT_V(n) asm volatile("s_waitcnt vmcnt(" #n ")" ::: "memory")
#define PG8_WAIT_L(n) asm volatile("s_waitcnt lgkmcnt(" #n ")" ::: "memory")
#define PG8_BAR __builtin_amdgcn_s_barrier()
#define PG8_SCHED __builtin_amdgcn_sched_barrier(0)
  Unit cur, nxt; int ui = 0;
  if (!S.next(0, cur)) return;
  f32x4 acc[2][2][4][2];
#pragma unroll
  for (int a = 0; a < 2; ++a)
#pragma unroll
    for (int b = 0; b < 2; ++b)
#pragma unroll
      for (int m = 0; m < 4; ++m)
#pragma unroll
        for (int n = 0; n < 2; ++n) acc[a][b][m][n] = (f32x4){0.f, 0.f, 0.f, 0.f};
  bf16x8 At[4][2], B0[2][2], B1[2][2];
  const char* cA = (const char*)g.A + (size_t)cur.pm * tstep; const char* cB = (const char*)g.Bt + (size_t)cur.pn * tstep;
  PG8_STAGE(PG8_SB(0, 0), cB, voffB); PG8_STAGE(PG8_SA(0, 0), cA, voffA); PG8_STAGE(PG8_SB(0, 1), cB + hstep, voffB); PG8_STAGE(PG8_SA(0, 1), cA + hstep, voffA);
  if (wr == 1) PG8_BAR;
  PG8_WAIT_V(4); PG8_BAR;
  PG8_STAGE(PG8_SB(1, 0), cB + kstep, voffB); PG8_STAGE(PG8_SA(1, 0), cA + kstep, voffA); PG8_STAGE(PG8_SB(1, 1), cB + hstep + kstep, voffB);
  PG8_WAIT_V(6); PG8_BAR;
  for (;;) {
    const bool has_next = S.next(ui + 1, nxt);
    const char* nA = has_next ? (const char*)g.A + (size_t)nxt.pm * tstep : cA; const char* nB = has_next ? (const char*)g.Bt + (size_t)nxt.pn * tstep : cB;
    for (int t = 0; t < nt; t += 2) {
      const bool last = (t == nt - 2);
      const char* a1 = cA + (size_t)(t + 1) * kstep;
      const char* a2 = last ? nA : cA + (size_t)(t + 2) * kstep; const char* b2 = last ? nB : cB + (size_t)(t + 2) * kstep;
      const char* a3 = a2 + kstep; const char* b3 = b2 + kstep;
      PG8_LDB(B0, 0, 0); PG8_SCHED; PG8_LDA(At, 0, 0); PG8_STAGE(PG8_SA(1, 1), a1 + hstep, voffA);
      PG8_WAIT_L(8); PG8_BAR; PG8_WAIT_L(0); PG8_MMA(0, 0, At, B0); PG8_BAR; PG8_SCHED;
      PG8_LDB(B1, 0, 1); PG8_STAGE(PG8_SB(0, 0), b2, voffB);
      PG8_BAR; PG8_WAIT_L(0); PG8_MMA(0, 1, At, B1); PG8_BAR;
      PG8_LDA(At, 0, 1); PG8_STAGE(PG8_SA(0, 0), a2, voffA);
      PG8_BAR; PG8_WAIT_L(0); PG8_MMA(1, 0, At, B0); PG8_BAR; PG8_SCHED;
      PG8_STAGE(PG8_SB(0, 1), b2 + hstep, voffB);
      PG8_WAIT_V(6); PG8_BAR; PG8_MMA(1, 1, At, B1); PG8_BAR;
      PG8_LDB(B0, 1, 0); PG8_SCHED; PG8_LDA(At, 1, 0); PG8_STAGE(PG8_SA(0, 1), a2 + hstep, voffA);
      PG8_WAIT_L(8); PG8_BAR; PG8_WAIT_L(0); PG8_MMA(0, 0, At, B0); PG8_BAR; PG8_SCHED;
      PG8_LDB(B1, 1, 1); PG8_STAGE(PG8_SB(1, 0), b3, voffB);
      PG8_BAR; PG8_WAIT_L(0); PG8_MMA(0, 1, At, B1); PG8_BAR;
      PG8_LDA(At, 1, 1); PG8_STAGE(PG8_SA(1, 0), a3, voffA);
      PG8_BAR; PG8_WAIT_L(0); PG8_MMA(1, 0, At, B0); PG8_BAR; PG8_SCHED;
      PG8_STAGE(PG8_SB(1, 1), b3 + hstep, voffB);
      PG8_WAIT_V(6); PG8_BAR; PG8_MMA(1, 1, At, B1); PG8_BAR;
    }
    E(acc, cur, wr, wc, fr, fq);
    if (!has_next) break;
#pragma unroll
    for (int a = 0; a < 2; ++a)
#pragma unroll
      for (int b = 0; b < 2; ++b)
#pragma unroll
        for (int m = 0; m < 4; ++m)
#pragma unroll
          for (int n = 0; n < 2; ++n) acc[a][b][m][n] = (f32x4){0.f, 0.f, 0.f, 0.f};
    cur = nxt; cA = nA; cB = nB; ++ui;
  }
  PG8_WAIT_V(0);
  if (wr == 0) PG8_BAR;
  PG8_BAR;
#undef PG8_SA
#undef PG8_SB
#undef PG8_STAGE
#undef PG8_LDA
#undef PG8_LDB
#undef PG8_MMA
#undef PG8_WAIT_V
#undef PG8_WAIT_L
#undef PG8_BAR
#undef PG8_SCHED
}

struct EpiProj {
  static constexpr bool PERM = true;
  u16* O; int ldc; float* out; int mode; const float* rs;
  DI void operator()(const f32x4 (&acc)[2][2][4][2], const Unit& u, int wr, int wc, int fr, int fq) const {
    const int row0 = u.pm * BM + wr * 64 + fr, colt = u.pn * BM, col0 = colt + wc * 32 + 8 * fq;
    const bool kv = (mode == 1) && colt >= 2048 && colt < 6144;
    const int sec = colt >= 4096 ? 1 : 0;
#pragma unroll
    for (int ai = 0; ai < 2; ++ai)
#pragma unroll
      for (int m = 0; m < 4; ++m) {
        const int row = row0 + ai * HALF + m * 16;
        u16* rowp = O + (size_t)row * ldc + col0;
        const float rr = rs ? rsqrtf(rs[row] * (1.f / 2048.f) + 1e-6f) : 1.f;
#pragma unroll
        for (int bj = 0; bj < 2; ++bj) {
          const f32x4 v0 = acc[ai][bj][m][0] * rr, v1 = acc[ai][bj][m][1] * rr;
          u32x4 w = {pack2(v0[0], v0[1]), pack2(v0[2], v0[3]), pack2(v1[0], v1[1]), pack2(v1[2], v1[3])};
          *reinterpret_cast<u32x4*>(rowp + bj * HALF) = w;
          if (kv) {
            const int c2 = col0 + bj * HALF - 2048 - sec * 2048;
            float* dst = row < PROWS ? out + (sec ? OFF_VP : OFF_KP) + (size_t)row * DM + c2 : out + (sec ? OFF_VS : OFF_KS) + (size_t)(row - PROWS) * DM + c2;
            __builtin_nontemporal_store(v0, reinterpret_cast<f32x4*>(dst)); __builtin_nontemporal_store(v1, reinterpret_cast<f32x4*>(dst + 4));
          }
        }
      }
  }
};
struct EpiRes {
  static constexpr bool PERM = true;
  const float* xp; const float* xs; float* out; int layer; const float* wn; u16* xw; float* rs;
  DI void operator()(const f32x4 (&acc)[2][2][4][2], const Unit& u, int wr, int wc, int fr, int fq) const {
    const int row0 = u.pm * BM + wr * 64 + fr, col0 = u.pn * BM + wc * 32 + 8 * fq;
    f32x4 wv[2][2];
#pragma unroll
    for (int bj = 0; bj < 2; ++bj)
#pragma unroll
      for (int n = 0; n < 2; ++n) wv[bj][n] = xw ? *reinterpret_cast<const f32x4*>(wn + col0 + bj * HALF + n * 4) : (f32x4){0.f, 0.f, 0.f, 0.f};
#pragma unroll
    for (int ai = 0; ai < 2; ++ai)
#pragma unroll
      for (int m = 0; m < 4; ++m) {
        const int row = row0 + ai * HALF + m * 16;
        float* dst = out + (size_t)row * DM + col0;
        const float* src = layer == 0 ? (row < PROWS ? xp + (size_t)row * DM + col0 : xs + (size_t)(row - PROWS) * DM + col0) : dst;
        float ss = 0.f;
#pragma unroll
        for (int bj = 0; bj < 2; ++bj) {
          const f32x4 x0 = *reinterpret_cast<const f32x4*>(src + bj * HALF), x1 = *reinterpret_cast<const f32x4*>(src + bj * HALF + 4);
          const f32x4 n0 = x0 + acc[ai][bj][m][0], n1 = x1 + acc[ai][bj][m][1];
          *reinterpret_cast<f32x4*>(dst + bj * HALF) = n0; *reinterpret_cast<f32x4*>(dst + bj * HALF + 4) = n1;
          ss += n0[0] * n0[0] + n0[1] * n0[1] + n0[2] * n0[2] + n0[3] * n0[3] + n1[0] * n1[0] + n1[1] * n1[1] + n1[2] * n1[2] + n1[3] * n1[3];
          if (xw) {
            const f32x4 h0 = n0 * wv[bj][0], h1 = n1 * wv[bj][1];
            u32x4 pk = {pack2(h0[0], h0[1]), pack2(h0[2], h0[3]), pack2(h1[0], h1[1]), pack2(h1[2], h1[3])};
            *reinterpret_cast<u32x4*>(xw + (size_t)row * DM + col0 + bj * HALF) = pk;
          }
        }
        ss += __shfl_xor(ss, 16); ss += __shfl_xor(ss, 32);
        if (fq == 0) atomicAdd(rs + row, ss);
      }
  }
};
}

template <class Epi>
DI void gemm8(char* smem, const u16* A, const u16* Bt, int N, const Epi& E) {
  pg8::Gemm g; g.A = A; g.Bt = Bt; g.M = MROWS; g.N = N; g.K = 2048;
  pg8::StaticOrder S; S.init(MROWS, N, gridDim.x, blockIdx.x);
  pg8::gemm_phase<Epi>((LAS unsigned char*)smem, g, S, E);
}

template <int KIND> struct RC {
  static constexpr int H = KIND == 0 ? 4 : 16;
  static constexpr int KH = KIND == 0 ? 256 : 128;
  static constexpr int VH = KIND == 0 ? 512 : 128;
  static constexpr int HPB = 256 / KH;
  static constexpr int LD = KIND == 0 ? GLA_LD : 8192;
  static constexpr int NIT = 264 * H;
  static constexpr int VOFF = KIND == 0 ? 2048 : 4096;
  static constexpr size_t SZQ = (size_t)NIT * 64 * KH;
  static constexpr size_t SZV = (size_t)NIT * VH * 64;
};

template <int KIND>
DI void prep_phase(const Params& p, int layer, int j, const u16* proj, char* prep, char* smem) {
  using C = RC<KIND>;
  constexpr int H = C::H, KH = C::KH, VH = C::VH, HPB = C::HPB, LD = C::LD, KTH = KH / 32;
  constexpr float L2E = 1.4426950408889634f, LN2 = 0.6931471805599453f;
  u16* QF = reinterpret_cast<u16*>(prep);
  u16* KF = QF + C::SZQ;
  u16* VF = KF + C::SZQ;
  u16* AF = VF + C::SZV;
  float* DL = reinterpret_cast<float*>(AF + (size_t)C::NIT * 4096);
  const int tid = opq(threadIdx.x), half = tid >> 8, c = tid & 255, lane = tid & 63, wvl = (tid >> 6) & 3, l31 = lane & 31, hh = lane >> 5;
  u16* qs = reinterpret_cast<u16*>(smem) + half * (2 * 64 * 264 + 64 * 16);
  u16* ks = qs + 64 * 264;
  u16* as = ks + 64 * 264;
  constexpr int HG = H / HPB;
  const int nblk = 264 * HG;
  for (int bi = blockIdx.x * 2 + half; bi < nblk; bi += gridDim.x * 2) {
    const int cgk = bi / HG, hg = bi - cgk * HG;
    const int nvalid = cgk < 256 ? 64 : 32;
    const size_t row0 = cgk < 256 ? (size_t)cgk * 64 : (size_t)PROWS + (size_t)(cgk - 256) * 32;
    const int head = hg * HPB + c / KH, kk = c % KH;
    const int item = cgk * H + head;
    float w2[16]; float ba = 0.f, lb = 0.f;
    if (KIND == 0) {
#pragma unroll
      for (int r = 0; r < 16; ++r) w2[r] = p.gla_w_a2[(size_t)j * 16 * 1024 + r * 1024 + head * 256 + kk];
      ba = p.gla_b_a[j * 1024 + head * 256 + kk];
    } else {
#pragma unroll
      for (int r = 0; r < 16; ++r) w2[r] = 0.f;
      const int ch = head * 128 + kk;
      float l0 = p.hgrn_lb[ch], l1 = p.hgrn_lb[2048 + ch], l2 = p.hgrn_lb[4096 + ch], l3 = p.hgrn_lb[6144 + ch];
      float mx = fmaxf(fmaxf(l0, l1), fmaxf(l2, l3));
      float e0 = expf(l0 - mx), e1 = expf(l1 - mx), e2 = expf(l2 - mx), e3 = expf(l3 - mx);
      float inv = 1.f / (e0 + e1 + e2 + e3);
      float acc = 0.f;
      if (layer >= 1) acc += e1;
      if (layer >= 2) acc += e2;
      if (layer >= 3) acc += e3;
      lb = acc * inv;
    }
    __syncthreads();
    {
      const u16* qsrc = proj + row0 * LD + hg * 256;
      const u16* ksrc = qsrc + (KIND == 0 ? 1024 : 2048);
#pragma unroll
      for (int i = 0; i < 8; ++i) {
        const int id = c + 256 * i, t = id >> 5, ch = id & 31;
        u32x4 vq = {0u, 0u, 0u, 0u}, vk = {0u, 0u, 0u, 0u};
        if (t < nvalid) {
          vq = *reinterpret_cast<const u32x4*>(qsrc + (size_t)t * LD + ch * 8);
          vk = *reinterpret_cast<const u32x4*>(ksrc + (size_t)t * LD + ch * 8);
        }
        *reinterpret_cast<u32x4*>(qs + t * 264 + ch * 8) = vq;
        *reinterpret_cast<u32x4*>(ks + t * 264 + ch * 8) = vk;
      }
      if (KIND == 0 && c < 128) {
        const int t = c >> 1, part = c & 1;
        u32x4 va = {0u, 0u, 0u, 0u};
        if (t < nvalid) va = *reinterpret_cast<const u32x4*>(proj + (row0 + t) * LD + 6144 + part * 8);
        *reinterpret_cast<u32x4*>(as + t * 16 + part * 8) = va;
      }
    }
    __syncthreads();
    float b = 0.f;
    {
      const int kt = kk >> 5, kl = kk & 31;
      u16* kfb = KF + (size_t)item * 64 * KH + ((size_t)(kt * 4) * 64 + kl) * 8;
#pragma unroll 2
      for (int t8 = 0; t8 < 8; ++t8) {
        u32 pk[4];
#pragma unroll
        for (int e = 0; e < 4; ++e) {
          u16 kb[2];
#pragma unroll
          for (int q = 0; q < 2; ++q) {
            const int t = t8 * 8 + 2 * e + q;
            const float qr = bf2f(qs[t * 264 + c]), kr = bf2f(ks[t * 264 + c]);
            float qv, kv, g;
            if (KIND == 0) {
              qv = qr * 0.0625f; kv = kr;
              const u32x4 a0 = *reinterpret_cast<const u32x4*>(as + t * 16);
              const u32x4 a1 = *reinterpret_cast<const u32x4*>(as + t * 16 + 8);
              float x = ba;
              x += bflo(a0.x) * w2[0] + bfhi(a0.x) * w2[1] + bflo(a0.y) * w2[2] + bfhi(a0.y) * w2[3];
              x += bflo(a0.z) * w2[4] + bfhi(a0.z) * w2[5] + bflo(a0.w) * w2[6] + bfhi(a0.w) * w2[7];
              x += bflo(a1.x) * w2[8] + bfhi(a1.x) * w2[9] + bflo(a1.y) * w2[10] + bfhi(a1.y) * w2[11];
              x += bflo(a1.z) * w2[12] + bfhi(a1.z) * w2[13] + bflo(a1.w) * w2[14] + bfhi(a1.w) * w2[15];
              const float ex = __builtin_amdgcn_exp2f(-fabsf(x) * L2E);
              g = (fminf(x, 0.f) - __builtin_amdgcn_logf(1.f + ex) * LN2) * 0.0625f;
            } else {
              qv = qr / (1.f + __builtin_amdgcn_exp2f(-qr * L2E)) * 0.08838834764831845f;
              const float sg = 1.f / (1.f + __builtin_amdgcn_exp2f(-kr * L2E));
              const float fg = lb + (1.f - lb) * sg;
              kv = 1.f - fg;
              g = __builtin_amdgcn_logf(fg) * LN2;
            }
            if (t >= nvalid) { qv = 0.f; kv = 0.f; g = 0.f; }
            b += g;
            qs[t * 264 + c] = f2bf(qv * __builtin_amdgcn_exp2f(b * L2E));
            kb[q] = f2bf(kv * __builtin_amdgcn_exp2f(fminf(-b, 80.f) * L2E));
            ks[t * 264 + c] = kb[q];
          }
          pk[e] = (u32)kb[0] | ((u32)kb[1] << 16);
        }
        u32x4 o = {pk[0], pk[1], pk[2], pk[3]};
        *reinterpret_cast<u32x4*>(kfb + ((size_t)((t8 >> 1) * 64 + (t8 & 1) * 32)) * 8) = o;
      }
    }
    DL[(size_t)item * KH + kk] = __builtin_amdgcn_exp2f(b * L2E);
    __syncthreads();
    for (int jb = wvl; jb < HPB * 4; jb += 4) {
      const int hl = jb >> 2, tr = (jb >> 1) & 1, tc = jb & 1;
      f32x16 acc = zero16();
      if (!(tr == 0 && tc == 1)) {
#pragma unroll
        for (int s = 0; s < KH / 16; ++s) {
          bf16x8 a = ld16(qs + (tr * 32 + l31) * 264 + hl * KH + s * 16 + hh * 8);
          bf16x8 bb = ld16(ks + (tc * 32 + l31) * 264 + hl * KH + s * 16 + hh * 8);
          acc = MFMA(a, bb, acc);
        }
      }
      u16* am = AF + (size_t)(cgk * H + hg * HPB + hl) * 4096;
      const int scol = tc * 32 + l31;
      const int s16 = scol >> 4, hs = (scol >> 3) & 1, jj = scol & 7;
#pragma unroll
      for (int reg = 0; reg < 16; ++reg) {
        const int tl = crow(reg, hh), t = tr * 32 + tl;
        am[((tr * 4 + s16) * 64 + hs * 32 + tl) * 8 + jj] = f2bf(scol <= t ? acc[reg] : 0.f);
      }
    }
#pragma unroll
    for (int i = 0; i < 8; ++i) {
      const int f = c + 256 * i, fl = f & 63, fi = f >> 6;
      const int mt = fi & 1, s = (fi >> 1) & 1, ktg = fi >> 2;
      const int hl = ktg / KTH, kt = ktg % KTH;
      const int t = mt * 32 + (fl & 31), fh = fl >> 5;
      const u16* src = qs + t * 264 + ktg * 32 + 16 * s + 4 * fh;
      const bf16x8 v = ld8x2(src, src + 8);
      *reinterpret_cast<bf16x8*>(QF + (size_t)(cgk * H + hg * HPB + hl) * 64 * KH + ((size_t)(((kt * 2 + s) * 2 + mt) * 64 + fl)) * 8) = v;
    }
#pragma unroll 1
    for (int pc = 0; pc < HPB * VH / 256; ++pc) {
      __syncthreads();
      {
        const u16* vsrc = proj + row0 * LD + C::VOFF + (hg * HPB) * VH + pc * 256;
#pragma unroll
        for (int i = 0; i < 8; ++i) {
          const int id = c + 256 * i, t = id >> 5, ch = id & 31;
          u32x4 vv = {0u, 0u, 0u, 0u};
          if (t < nvalid) vv = *reinterpret_cast<const u32x4*>(vsrc + (size_t)t * LD + ch * 8);
          *reinterpret_cast<u32x4*>(qs + t * 264 + ch * 8) = vv;
        }
      }
      __syncthreads();
      const int cv = pc * 256 + c;
      const int hl = cv / VH, v = cv % VH;
      u16* dst = VF + (size_t)(cgk * H + hg * HPB + hl) * VH * 64 + ((size_t)((v >> 5) * 4) * 64 + (v & 31)) * 8;
#pragma unroll
      for (int t8 = 0; t8 < 8; ++t8) {
        u32 pk[4];
#pragma unroll
        for (int e = 0; e < 4; ++e) {
          const int t = t8 * 8 + 2 * e;
          pk[e] = (u32)qs[t * 264 + c] | ((u32)qs[(t + 1) * 264 + c] << 16);
        }
        u32x4 o = {pk[0], pk[1], pk[2], pk[3]};
        *reinterpret_cast<u32x4*>(dst + ((size_t)((t8 >> 1) * 64 + (t8 & 1) * 32)) * 8) = o;
      }
    }
  }
}

template <int NA_> struct SeqOps { bf16x8 q[2][2]; bf16x8 k[4]; bf16x8 v[4]; bf16x8 a[NA_]; float4 dl[4]; };

template <int KIND>
DI void seq_phase(const Params& p, int j, const char* prep, u16* obuf, char* smem) {
  using C = RC<KIND>;
  constexpr int H = C::H, KH = C::KH, VH = C::VH, WPI = KH / 32, IPB = 8 / WPI, NA = 8 / WPI, NVS = VH / 32, NV = 32 / WPI;
  const u16* QF = reinterpret_cast<const u16*>(prep);
  const u16* KF = QF + C::SZQ;
  const u16* VF = KF + C::SZQ;
  const u16* AF = VF + C::SZV;
  const float* DL = reinterpret_cast<const float*>(AF + (size_t)C::NIT * 4096);
  float* red = reinterpret_cast<float*>(smem);
  const int tid = opq(threadIdx.x), lane = tid & 63, wv = __builtin_amdgcn_readfirstlane(tid >> 6), l31 = lane & 31, hh = lane >> 5;
  const int grp = wv / WPI, wg = wv % WPI, kt = wg;
  constexpr int nitems = 12 * H * NVS, nbitems = nitems / IPB;
  constexpr size_t SSZ = (size_t)H * KH * VH;
  int cnt = 0;
  for (int bitem = blockIdx.x; bitem < nbitems; bitem += gridDim.x) {
    int bsel = bitem;
    {
      constexpr int PER_BH = NVS / IPB, NBH = 4 * H, NPB = NBH * PER_BH;
      if (bitem < NPB) { const int x = bitem & 7, i = bitem >> 3; bsel = (x * (NBH / 8) + i / PER_BH) * PER_BH + i % PER_BH; }
    }
    const int it = bsel * IPB + grp;
    const int seq = it / (H * NVS), rem = it % (H * NVS), head = rem / NVS, vs = rem % NVS;
    const size_t sbase = (size_t)head * KH * VH + (size_t)(kt * 32) * VH + vs * 32 + l31;
    float* st_out;
    if (KIND == 0) st_out = seq < 4 ? p.out + OFF_GSP + (size_t)(j * 4 + seq) * SSZ : p.out + OFF_GSS + (size_t)(j * 8 + seq - 4) * SSZ;
    else st_out = seq < 4 ? p.out + OFF_HSP + (size_t)seq * SSZ : p.out + OFF_HSS + (size_t)(seq - 4) * SSZ;
    f32x16 S;
    if (seq >= 4) {
      const float* st_in = (KIND == 0 ? p.state_gla + (size_t)j * 8 * SSZ : p.state_hgrn) + (size_t)(seq - 4) * SSZ;
#pragma unroll
      for (int reg = 0; reg < 16; ++reg) S[reg] = st_in[sbase + (size_t)crow(reg, hh) * VH];
    } else {
      S = zero16();
    }
    const int nch = seq < 4 ? 64 : 1;
    const int cg0 = seq < 4 ? seq * 64 : 256 + seq - 4;
    const int nvalid = seq < 4 ? 64 : 32;
    SeqOps<NA> cur, nxt;
    auto load_ops = [&](SeqOps<NA>& o, int cgk) {
      const size_t item = (size_t)cgk * H + head;
      const u16* qb = QF + item * 64 * KH + (size_t)(kt * 4) * 512 + lane * 8;
#pragma unroll
      for (int s = 0; s < 2; ++s)
#pragma unroll
        for (int mt = 0; mt < 2; ++mt) o.q[s][mt] = ld16(qb + (s * 2 + mt) * 512);
      const u16* kb = KF + item * 64 * KH + (size_t)(kt * 4) * 512 + lane * 8;
#pragma unroll
      for (int s16 = 0; s16 < 4; ++s16) o.k[s16] = ld16(kb + s16 * 512);
      const u16* vb = VF + item * VH * 64 + (size_t)(vs * 4) * 512 + lane * 8;
#pragma unroll
      for (int s16 = 0; s16 < 4; ++s16) o.v[s16] = ld16(vb + s16 * 512);
#pragma unroll
      for (int i = 0; i < NA; ++i) o.a[i] = ld16(AF + item * 4096 + (size_t)(wg * NA + i) * 512 + lane * 8);
      const float* db = DL + item * KH + kt * 32 + 4 * hh;
#pragma unroll
      for (int g4 = 0; g4 < 4; ++g4) o.dl[g4] = *reinterpret_cast<const float4*>(db + 8 * g4);
    };
    load_ops(cur, cg0);
    constexpr bool DEFER = true;
    u32 osum[NV / 2];
    auto store_o = [&](size_t prow0) {
#pragma unroll
      for (int i = 0; i < NV; ++i) {
        const int vec = wg * NV + i;
        const int t = (vec >> 4) * 32 + crow(vec & 15, hh);
        if (t < nvalid) obuf[(prow0 + t) * DM + head * VH + vs * 32 + l31] = (u16)((i & 1) ? (osum[i >> 1] >> 16) : (osum[i >> 1] & 0xffffu));
      }
    };
    for (int ch = 0; ch < nch; ++ch) {
      if (DEFER && ch > 0) store_o((size_t)(cg0 + ch - 1) * 64);
      if (ch + 1 < nch) load_ops(nxt, cg0 + ch + 1);
      const size_t row0 = seq < 4 ? (size_t)(cg0 + ch) * 64 : (size_t)PROWS + (size_t)(seq - 4) * 32;
      f32x16 O[2]; O[0] = zero16(); O[1] = zero16();
      {
        const bf16x8 b0 = packacc<0>(S), b1 = packacc<1>(S);
        O[0] = MFMA(cur.q[0][0], b0, O[0]);
        O[1] = MFMA(cur.q[0][1], b0, O[1]);
        O[0] = MFMA(cur.q[1][0], b1, O[0]);
        O[1] = MFMA(cur.q[1][1], b1, O[1]);
      }
#pragma unroll
      for (int i = 0; i < NA; ++i) {
        const int pi = wg * NA + i;
#pragma unroll
        for (int mc = 0; mc < 2; ++mc)
#pragma unroll
          for (int sc = 0; sc < 4; ++sc)
            if (pi == mc * 4 + sc) O[mc] = MFMA(cur.a[i], cur.v[sc], O[mc]);
      }
      u32* rp = reinterpret_cast<u32*>(red) + ((size_t)((cnt & 1) * 8 + wv) * 16) * 64 + lane;
#pragma unroll
      for (int mt = 0; mt < 2; ++mt)
#pragma unroll
        for (int r2 = 0; r2 < 8; ++r2) rp[(mt * 8 + r2) * 64] = pack2(O[mt][2 * r2], O[mt][2 * r2 + 1]);
#pragma unroll
      for (int s16 = 0; s16 < 4; ++s16) S = MFMA(cur.k[s16], cur.v[s16], S);
#pragma unroll
      for (int g4 = 0; g4 < 4; ++g4) {
        S[4 * g4 + 0] *= cur.dl[g4].x; S[4 * g4 + 1] *= cur.dl[g4].y; S[4 * g4 + 2] *= cur.dl[g4].z; S[4 * g4 + 3] *= cur.dl[g4].w;
      }
      asm volatile("s_waitcnt lgkmcnt(0)" ::: "memory");
      __builtin_amdgcn_s_barrier();
      asm volatile("" ::: "memory");
      {
        const u32* rg = reinterpret_cast<const u32*>(red) + ((size_t)((cnt & 1) * 8 + grp * WPI) * 16) * 64 + lane;
#pragma unroll
        for (int i = 0; i < NV; i += 2) {
          float sum0 = 0.f, sum1 = 0.f;
#pragma unroll
          for (int w2 = 0; w2 < WPI; ++w2) { const u32 pk = rg[((size_t)w2 * 16 + (wg * NV + i) / 2) * 64]; sum0 += bflo(pk); sum1 += bfhi(pk); }
          osum[i >> 1] = pack2(sum0, sum1);
        }
        if (!DEFER) store_o(row0);
      }
      ++cnt;
      if (ch + 1 < nch) cur = nxt;
    }
    if (DEFER) store_o(seq < 4 ? (size_t)(cg0 + nch - 1) * 64 : (size_t)PROWS + (size_t)(seq - 4) * 32);
#pragma unroll
    for (int reg = 0; reg < 16; ++reg) st_out[sbase + (size_t)crow(reg, hh) * VH] = S[reg];
  }
}

DI void gate_phase(u16* hb, const u16* proj, int ld, int zoff, const float* w, int G, float scale) {
  const int tid = opq(threadIdx.x); const int lane = tid & 63, wv = tid >> 6;
  for (int row = blockIdx.x * 8 + wv; row < MROWS; row += gridDim.x * 8) {
    u32x2* hp = reinterpret_cast<u32x2*>(hb + (size_t)row * DM);
    const u32x2* zp = reinterpret_cast<const u32x2*>(proj + (size_t)row * ld + zoff);
    float o[8][4], ss[8];
#pragma unroll
    for (int i = 0; i < 8; ++i) {
      const u32x2 pk = hp[i * 64 + lane];
      o[i][0] = bflo(pk.x); o[i][1] = bfhi(pk.x); o[i][2] = bflo(pk.y); o[i][3] = bfhi(pk.y);
      ss[i] = o[i][0] * o[i][0] + o[i][1] * o[i][1] + o[i][2] * o[i][2] + o[i][3] * o[i][3];
    }
#pragma unroll
    for (int i = 0; i < 8; ++i) ss[i] = wave_sum(ss[i]);
    if (G == 512) {
#pragma unroll
      for (int i = 0; i < 8; i += 2) { const float t = ss[i] + ss[i + 1]; ss[i] = t; ss[i + 1] = t; }
    } else if (G == 2048) {
      float t = 0.f;
#pragma unroll
      for (int i = 0; i < 8; ++i) t += ss[i];
#pragma unroll
      for (int i = 0; i < 8; ++i) ss[i] = t;
    }
    const float invG = 1.f / (float)G;
#pragma unroll
    for (int i = 0; i < 8; ++i) {
      const float r = rsqrtf(ss[i] * invG + 1e-6f) * scale;
      const int col = i * 256 + lane * 4;
      const float4 ww = *reinterpret_cast<const float4*>(w + (col & (G - 1)));
      const u32x2 zk = zp[i * 64 + lane];
      const float z0 = bflo(zk.x), z1 = bfhi(zk.x), z2 = bflo(zk.y), z3 = bfhi(zk.y);
      const float g0 = o[i][0] * r * ww.x * (z0 / (1.f + expf(-z0)));
      const float g1 = o[i][1] * r * ww.y * (z1 / (1.f + expf(-z1)));
      const float g2 = o[i][2] * r * ww.z * (z2 / (1.f + expf(-z2)));
      const float g3 = o[i][3] * r * ww.w * (z3 / (1.f + expf(-z3)));
      u32x2 ov = {pack2(g0, g1), pack2(g2, g3)};
      hp[i * 64 + lane] = ov;
    }
  }
}

constexpr size_t SZ_VTP = (size_t)4 * 8 * 256 * 4096;
constexpr size_t SZ_KS = (size_t)8 * 16 * 1088 * 128;
DI void diffprep_cache(const Params& p, char* prep, int rank, int nranks) {
  u16* VTP = reinterpret_cast<u16*>(prep);
  u16* KS = VTP + SZ_VTP;
  u16* VTS = KS + SZ_KS;
  const int tid0 = opq(threadIdx.x), half = tid0 >> 8, tid = tid0 & 255;
  for (int it = rank * 2 + half; it < 8 * 8 * 16; it += nranks * 2) {
    const int kt = it & 15, bh = it >> 4, b = bh >> 3, h = bh & 7;
    u16* dst = VTS + ((size_t)((b * 8 + h) * 256 + tid)) * 1088 + kt * 64;
    const float* src = p.cache_v + ((size_t)(b * 1024 + kt * 64) * 8 + h) * 256 + tid;
#pragma unroll
    for (int g16 = 0; g16 < 4; ++g16) {
      float v[16];
#pragma unroll
      for (int e = 0; e < 16; ++e) v[e] = __builtin_nontemporal_load(src + (size_t)(g16 * 16 + e) * 2048);
      u32x4 o0 = {pack2(v[0], v[1]), pack2(v[2], v[3]), pack2(v[8], v[9]), pack2(v[10], v[11])};
      u32x4 o1 = {pack2(v[4], v[5]), pack2(v[6], v[7]), pack2(v[12], v[13]), pack2(v[14], v[15])};
      *reinterpret_cast<u32x4*>(dst + g16 * 16) = o0;
      *reinterpret_cast<u32x4*>(dst + g16 * 16 + 8) = o1;
    }
  }
  const int nchunks = 8 * 16 * 1024 * 16;
  for (int id = rank * 512 + tid0; id < nchunks; id += nranks * 512) {
    const int d8 = id & 15, rest = id >> 4, key = rest & 1023, bn = rest >> 10, b = bn >> 4, n = bn & 15;
    const float4* sp = reinterpret_cast<const float4*>(p.cache_k + ((size_t)(b * 1024 + key) * 16 + n) * 128 + d8 * 8);
    const float4 a = sp[0], c = sp[1];
    u32x4 o = {pack2(a.x, a.y), pack2(a.z, a.w), pack2(c.x, c.y), pack2(c.z, c.w)};
    *reinterpret_cast<u32x4*>(KS + ((size_t)(b * 16 + n) * 1088 + key) * 128 + d8 * 8) = o;
  }
}
DI void diffprep_phase(const Params& p, const u16* proj, char* prep, char* smem) {
  u16* VTP = reinterpret_cast<u16*>(prep);
  u16* KS = VTP + SZ_VTP;
  u16* VTS = KS + SZ_KS;
  const int tid0 = opq(threadIdx.x), half = tid0 >> 8, tid = tid0 & 255;
  u16* tl = reinterpret_cast<u16*>(smem) + half * (64 * 264);
  for (int it = blockIdx.x * 2 + half; it < 2048; it += gridDim.x * 2) {
    const int h = it & 7, c = (it >> 3) & 63, b = it >> 9;
    const u16* src = proj + (size_t)(b * 4096 + c * 64) * 8192 + 4096 + h * 256;
    __syncthreads();
#pragma unroll
    for (int i = 0; i < 8; ++i) {
      const int id = tid + 256 * i, t = id >> 5, ch = id & 31;
      *reinterpret_cast<u32x4*>(tl + t * 264 + ch * 8) = *reinterpret_cast<const u32x4*>(src + (size_t)t * 8192 + ch * 8);
    }
    __syncthreads();
    u16* dst = VTP + ((size_t)((b * 8 + h) * 256 + tid)) * 4096 + c * 64;
#pragma unroll
    for (int g16 = 0; g16 < 4; ++g16) {
      u32 pk[8];
#pragma unroll
      for (int e = 0; e < 8; ++e) {
        const int t = g16 * 16 + 2 * e;
        pk[e] = (u32)tl[t * 264 + tid] | ((u32)tl[(t + 1) * 264 + tid] << 16);
      }
      u32x4 o0 = {pk[0], pk[1], pk[4], pk[5]}, o1 = {pk[2], pk[3], pk[6], pk[7]};
      *reinterpret_cast<u32x4*>(dst + g16 * 16) = o0;
      *reinterpret_cast<u32x4*>(dst + g16 * 16 + 8) = o1;
    }
  }
  for (int it = blockIdx.x * 2 + half; it < 8 * 8; it += gridDim.x * 2) {
    const int b = it >> 3, h = it & 7;
    u16* dst = VTS + ((size_t)((b * 8 + h) * 256 + tid)) * 1088 + 16 * 64;
#pragma unroll
    for (int g16 = 0; g16 < 4; ++g16) {
      u32 pk[8];
#pragma unroll
      for (int e = 0; e < 8; ++e) {
        const int k0 = g16 * 16 + 2 * e;
        const u32 lo = k0 < 32 ? (u32)proj[(size_t)(PROWS + b * 32 + k0) * 8192 + 4096 + h * 256 + tid] : 0u;
        const u32 hi = k0 + 1 < 32 ? (u32)proj[(size_t)(PROWS + b * 32 + k0 + 1) * 8192 + 4096 + h * 256 + tid] : 0u;
        pk[e] = lo | (hi << 16);
      }
      u32x4 o0 = {pk[0], pk[1], pk[4], pk[5]}, o1 = {pk[2], pk[3], pk[6], pk[7]};
      *reinterpret_cast<u32x4*>(dst + g16 * 16) = o0;
      *reinterpret_cast<u32x4*>(dst + g16 * 16 + 8) = o1;
    }
  }
  const int nchunks = 8 * 16 * 64 * 16;
  for (int id = blockIdx.x * 512 + tid0; id < nchunks; id += gridDim.x * 512) {
    const int d8 = id & 15, rest = id >> 4, kl = rest & 63, bn = rest >> 6, b = bn >> 4, n = bn & 15;
    u32x4 o = {0u, 0u, 0u, 0u};
    if (kl < 32) o = *reinterpret_cast<const u32x4*>(proj + (size_t)(PROWS + b * 32 + kl) * 8192 + 2048 + n * 128 + d8 * 8);
    *reinterpret_cast<u32x4*>(KS + ((size_t)(b * 16 + n) * 1088 + 1024 + kl) * 128 + d8 * 8) = o;
  }
}

DI void attn_phase(const Params& p, const u16* proj, const char* prep, u16* obuf, char* smem) {
  const u16* VTP = reinterpret_cast<const u16*>(prep);
  const u16* KS = VTP + SZ_VTP;
  const u16* VTS = KS + SZ_KS;
  constexpr int BUFE = 2 * 64 * 136 + 256 * 72;
  u16* lds = reinterpret_cast<u16*>(smem);
  float* Ot = reinterpret_cast<float*>(smem);
  const int tid = opq(threadIdx.x), lane = tid & 63, wv = __builtin_amdgcn_readfirstlane(tid >> 6), l31 = lane & 31, hh = lane >> 5;
  const int qt = wv & 1, jh = (wv >> 1) & 1, vh = wv >> 2;
  const int G = gridDim.x;
  bool xcdmap = (G == 256);
  int xx = (int)blockIdx.x & 7, yy = (int)blockIdx.x >> 3;
  if (xcdmap) {
    const unsigned* bar = reinterpret_cast<const unsigned*>(p.ws + WS_BAR);
    bool even = true;
#pragma unroll
    for (int jx = 0; jx < 8; ++jx) even = even && (bar[256 + 64 * jx] == 32u);
    if (even) {
      const unsigned sl = reinterpret_cast<volatile unsigned*>(smem + LDS_BYTES - 16)[2];
      xx = (int)(sl >> 16) & 7; yy = (int)(sl & 31u);
    }
  }
  xx = __builtin_amdgcn_readfirstlane(xx); yy = __builtin_amdgcn_readfirstlane(yy);
  const int nrounds = xcdmap ? 9 : (2048 + 64 + G - 1) / G;
  for (int r = 0; r < nrounds; ++r) {
    int i;
    if (xcdmap) {
      const int x = xx, y = yy;
      if (r < 8) { const int bh = x * 4 + (r >> 1), c = (r & 1) ? y : 63 - y; i = ((63 - c) << 5) | bh; }
      else { i = (x * 32 + y) < 64 ? 2048 + (x * 32 + y) : 1 << 30; }
    } else {
      i = r * G + (int)blockIdx.x;
    }
    if (i >= 2048 + 64) continue;
    int b, h, nt, nkeys, nq; size_t qrow0, kstride, khs, vtstride; const u16* kbase; const u16* vtbase;
    if (i < 2048) {
      const int c = 63 - (i >> 5), bh = i & 31; b = bh >> 3; h = bh & 7; nt = c + 1; nkeys = nt * 64; nq = 64;
      qrow0 = (size_t)b * 4096 + c * 64;
      kbase = proj + (size_t)(b * 4096) * 8192 + 2048 + (2 * h) * 128; kstride = 8192; khs = 128;
      vtbase = VTP + (size_t)((b * 8 + h) * 256) * 4096; vtstride = 4096;
    } else {
      const int bh = i - 2048; b = bh >> 3; h = bh & 7; nt = 17; nkeys = 1056; nq = 32;
      qrow0 = (size_t)PROWS + b * 32;
      kbase = KS + (size_t)((b * 16 + 2 * h) * 1088) * 128; kstride = 128; khs = (size_t)1088 * 128;
      vtbase = VTS + (size_t)((b * 8 + h) * 256) * 1088; vtstride = 1088;
    }
    bf16x8 Qf[8];
    {
      const size_t qrow = qrow0 + ((qt * 32 < nq) ? qt * 32 : 0) + l31;
      const u16* qp = proj + qrow * 8192 + (2 * h + jh) * 128 + hh * 8;
#pragma unroll
      for (int s = 0; s < 8; ++s) Qf[s] = ld16(qp + s * 16);
#pragma unroll
      for (int s = 0; s < 8; ++s) asm volatile("" : "+v"(Qf[s]));
    }
    u32x4 kr[4], vr[4];
    auto gload = [&](int kt) {
#pragma unroll
      for (int ii = 0; ii < 4; ++ii) {
        const int id = tid + 512 * ii;
        const int jl = id >> 10, key = (id >> 4) & 63, ch = id & 15;
        kr[ii] = *reinterpret_cast<const u32x4*>(kbase + jl * khs + (size_t)(kt * 64 + key) * kstride + ch * 8);
        const int vd = id >> 3, cv = id & 7;
        vr[ii] = *reinterpret_cast<const u32x4*>(vtbase + (size_t)vd * vtstride + kt * 64 + cv * 8);
      }
    };
    auto sstore = [&](int buf) {
      u16* Ks = lds + buf * BUFE; u16* Vt = Ks + 2 * 64 * 136;
#pragma unroll
      for (int ii = 0; ii < 4; ++ii) {
        const int id = tid + 512 * ii;
        const int jl = id >> 10, key = (id >> 4) & 63, ch = id & 15;
        *reinterpret_cast<u32x4*>(Ks + (jl * 64 + key) * 136 + ch * 8) = kr[ii];
        const int vd = id >> 3, cv = id & 7;
        *reinterpret_cast<u32x4*>(Vt + vd * 72 + cv * 8) = vr[ii];
      }
    };
    float m = -1e30f, l = 0.f;
    f32x16 O[4];
#pragma unroll
    for (int vt = 0; vt < 4; ++vt) O[vt] = zero16();
#define ATT_BAR() do { asm volatile("s_waitcnt lgkmcnt(0)" ::: "memory"); __builtin_amdgcn_s_barrier(); asm volatile("" ::: "memory"); } while (0)
    const bool grpB = vh != 0;
    gload(0);
    __syncthreads();
    sstore(0);
    __syncthreads();
    if (nt > 1) gload(1);
    if (grpB) ATT_BAR();
    for (int kt = 0; kt < nt; ++kt) {
      const u16* Ks = lds + (kt & 1) * BUFE; const u16* Vt = Ks + 2 * 64 * 136;
      f32x16 st[2];
      __builtin_amdgcn_s_setprio(1);
#pragma unroll
      for (int kti = 0; kti < 2; ++kti) {
        st[kti] = zero16();
#pragma unroll
        for (int s = 0; s < 8; ++s) {
          const bf16x8 a = ld16(Ks + (jh * 64 + kti * 32 + l31) * 136 + s * 16 + hh * 8);
          st[kti] = MFMA(a, Qf[s], st[kti]);
        }
      }
      __builtin_amdgcn_s_setprio(0);
      constexpr float SC = 0.08838834764831845f * 1.4426950408889634f;
      if ((kt + 1) * 64 > nkeys) {
#pragma unroll
        for (int kti = 0; kti < 2; ++kti)
#pragma unroll
          for (int reg = 0; reg < 16; ++reg)
            if (kt * 64 + kti * 32 + crow(reg, hh) >= nkeys) st[kti][reg] = -1e30f;
      }
      float mx = -1e30f;
#pragma unroll
      for (int kti = 0; kti < 2; ++kti)
#pragma unroll
        for (int reg = 0; reg < 16; ++reg) mx = fmaxf(mx, st[kti][reg]);
      mx = fmaxf(mx, __shfl_xor(mx, 32)) * SC;
      const float mn = fmaxf(m, mx);
      float rs = 0.f;
#pragma unroll
      for (int kti = 0; kti < 2; ++kti)
#pragma unroll
        for (int reg = 0; reg < 16; ++reg) {
          const float pv = __builtin_amdgcn_exp2f(st[kti][reg] * SC - mn);
          st[kti][reg] = pv; rs += pv;
        }
      rs += __shfl_xor(rs, 32);
      if (__any(mn != m)) {
        const float alpha = __builtin_amdgcn_exp2f(m - mn);
        l *= alpha;
#pragma unroll
        for (int vt = 0; vt < 4; ++vt)
#pragma unroll
          for (int reg = 0; reg < 16; ++reg) O[vt][reg] *= alpha;
      }
      l += rs; m = mn;
      if (grpB && kt + 1 < nt) { sstore((kt + 1) & 1); if (kt + 2 < nt) gload(kt + 2); }
      ATT_BAR();
      __builtin_amdgcn_s_setprio(1);
#pragma unroll
      for (int kti = 0; kti < 2; ++kti) {
        {
          const bf16x8 pf = packacc<0>(st[kti]);
#pragma unroll
          for (int vt = 0; vt < 4; ++vt) {
            O[vt] = MFMA(ld16(Vt + ((vh * 4 + vt) * 32 + l31) * 72 + kti * 32 + 8 * hh), pf, O[vt]);
          }
        }
        {
          const bf16x8 pf = packacc<1>(st[kti]);
#pragma unroll
          for (int vt = 0; vt < 4; ++vt) {
            O[vt] = MFMA(ld16(Vt + ((vh * 4 + vt) * 32 + l31) * 72 + kti * 32 + 16 + 8 * hh), pf, O[vt]);
          }
        }
      }
      __builtin_amdgcn_s_setprio(0);
      if (!grpB && kt + 1 < nt) { sstore((kt + 1) & 1); if (kt + 2 < nt) gload(kt + 2); }
      ATT_BAR();
    }
    if (!grpB) ATT_BAR();
#undef ATT_BAR
    const float inv = 1.f / l;
    float lam;
    {
      const float* lp = p.diff_lambda;
      float s1 = lp[lane] * lp[128 + lane] + lp[64 + lane] * lp[192 + lane];
      float s2 = lp[256 + lane] * lp[384 + lane] + lp[320 + lane] * lp[448 + lane];
      s1 = wave_sum(s1); s2 = wave_sum(s2);
      lam = expf(s1) - expf(s2) + LAM_INIT;
    }
    if (jh == 1) {
#pragma unroll
      for (int vt = 0; vt < 4; ++vt)
#pragma unroll
        for (int reg = 0; reg < 16; ++reg) Ot[(qt * 32 + l31) * 257 + (vh * 4 + vt) * 32 + crow(reg, hh)] = lam * O[vt][reg] * inv;
    }
    __syncthreads();
    if (jh == 0) {
#pragma unroll
      for (int vt = 0; vt < 4; ++vt)
#pragma unroll
        for (int reg = 0; reg < 16; ++reg) {
          const int idx = (qt * 32 + l31) * 257 + (vh * 4 + vt) * 32 + crow(reg, hh);
          Ot[idx] = O[vt][reg] * inv - Ot[idx];
        }
    }
    __syncthreads();
    {
#pragma unroll 1
      for (int rr = 0; rr < 8; ++rr) {
        const int q = wv * 8 + rr;
        const float a0 = Ot[q * 257 + lane], a1 = Ot[q * 257 + 64 + lane], a2 = Ot[q * 257 + 128 + lane], a3 = Ot[q * 257 + 192 + lane];
        float ss = wave_sum(a0 * a0 + a1 * a1 + a2 * a2 + a3 * a3);
        if (lane == 0) Ot[q * 257 + 256] = rsqrtf(ss * (1.f / 256.f) + 1e-6f) * (1.f - LAM_INIT);
      }
    }
    __syncthreads();
    {
      u32 zk[16];
      const int te = opq(tid);
#pragma unroll
      for (int ii = 0; ii < 16; ++ii) {
        const int id = te + 512 * ii, q = id >> 7, vd = (id & 127) * 2;
        zk[ii] = *reinterpret_cast<const u32*>(proj + (qrow0 + (q < nq ? q : 0)) * 8192 + 6144 + h * 256 + vd);
      }
      const int vd0 = (te & 127) * 2;
      const float w0 = p.diff_subln_w[vd0], w1 = p.diff_subln_w[vd0 + 1];
#pragma unroll
      for (int ii = 0; ii < 16; ++ii) {
        const int id = te + 512 * ii, q = id >> 7, vd = (id & 127) * 2;
        if (q < nq) {
          const float r = Ot[q * 257 + 256];
          const float z0 = bflo(zk[ii]), z1 = bfhi(zk[ii]);
          const float g0 = Ot[q * 257 + vd] * r * w0 * (z0 / (1.f + __builtin_amdgcn_exp2f(-z0 * 1.4426950408889634f)));
          const float g1 = Ot[q * 257 + vd + 1] * r * w1 * (z1 / (1.f + __builtin_amdgcn_exp2f(-z1 * 1.4426950408889634f)));
          *reinterpret_cast<u32*>(obuf + (qrow0 + q) * DM + h * 256 + vd) = pack2(g0, g1);
        }
      }
    }
  }
}

#define XB_TMO      128
#define XB_XCNT(j)  (256  + 64 * (j))
#define XB_XSUB(j)  (1280 + 64 * (j))
#define XB_XGEN(j)  (2304 + 64 * (j))
#define XB_TOP      3328
#define XB_TOPGEN   3392
#define XCD_BAR_WORDS 3456
#define XB_SPIN_CAP (1u << 18)
DI unsigned xb_ld(unsigned* p) { return __hip_atomic_load(p, __ATOMIC_RELAXED, __HIP_MEMORY_SCOPE_AGENT); }
DI unsigned xb_add(unsigned* p, unsigned v) { return __hip_atomic_fetch_add(p, v, __ATOMIC_RELAXED, __HIP_MEMORY_SCOPE_AGENT); }
DI unsigned xb_xcc_id() { return (unsigned)__builtin_amdgcn_s_getreg((3 << 11) | 20) & 0xFu; }
#define XB_SPIN(cond, bar) do { unsigned _sp = 0; while (cond) { __builtin_amdgcn_s_sleep(1); \
    if ((++_sp & 255u) == 0u) { if (xb_ld(&(bar)[XB_TMO])) break; if (_sp > XB_SPIN_CAP) { atomicAdd(&(bar)[XB_TMO], 1u); break; } } } } while (0)
struct XcdBarrier { unsigned* bar; unsigned x; volatile LAS unsigned* st; };
DI XcdBarrier xcd_barrier_post(unsigned* bar, volatile LAS unsigned* st) {
  XcdBarrier b; b.bar = bar; b.x = xb_xcc_id(); b.st = st;
  if (threadIdx.x == 0) (void)xb_add(&bar[XB_XCNT(b.x)], 1u);
  return b;
}
DI void xcd_barrier_complete(unsigned* bar, unsigned x, unsigned& nloc, unsigned& nx) {
  const unsigned G = gridDim.x * gridDim.y * gridDim.z;
  unsigned sum, cnt, mine, sp = 0u;
  for (;;) {
    sum = 0u; cnt = 0u; mine = 0u;
#pragma unroll
    for (unsigned j = 0; j < 16; ++j) { const unsigned c = xb_ld(&bar[XB_XCNT(j)]); sum += c; cnt += (c > 0u) ? 1u : 0u; mine = (j == x) ? c : mine; }
    if (sum == G) break;
    __builtin_amdgcn_s_sleep(1);
    if ((++sp & 255u) == 0u) { if (xb_ld(&bar[XB_TMO])) break; if (sp > XB_SPIN_CAP) { atomicAdd(&bar[XB_TMO], 1u); break; } }
  }
  nloc = mine > 0u ? mine : 1u; nx = cnt > 0u ? cnt : 1u;
}
DI void xcd_barrier(const XcdBarrier& b) {
  asm volatile("s_waitcnt vmcnt(0)" ::: "memory");
  __syncthreads();
  if (threadIdx.x == 0) {
    unsigned* bar = b.bar;
    __builtin_amdgcn_s_waitcnt(0);
    unsigned nloc = b.st[0], nx = b.st[1];
    if (nloc == 0u) { xcd_barrier_complete(bar, b.x, nloc, nx); b.st[0] = nloc; b.st[1] = nx; }
    const unsigned old = xb_add(&bar[XB_XSUB(b.x)], 1u);
    const unsigned gen = old / nloc;
    if (old + 1u == (gen + 1u) * nloc) {
      __builtin_amdgcn_fence(__ATOMIC_RELEASE, "agent");
      asm volatile("s_waitcnt vmcnt(0)" ::: "memory");
      const unsigned og = xb_add(&bar[XB_TOP], 1u);
      const unsigned tg = og / nx;
      if (og + 1u == (tg + 1u) * nx) xb_add(&bar[XB_TOPGEN], 1u);
      else XB_SPIN(xb_ld(&bar[XB_TOPGEN]) == tg, bar);
      __builtin_amdgcn_fence(__ATOMIC_ACQUIRE, "agent");
      xb_add(&bar[XB_XGEN(b.x)], 1u);
      asm volatile("s_waitcnt vmcnt(0)" ::: "memory");
    } else {
      XB_SPIN(xb_ld(&bar[XB_XGEN(b.x)]) == gen, bar);
      __builtin_amdgcn_fence(__ATOMIC_ACQUIRE, "agent");
      asm volatile("s_waitcnt vmcnt(0)" ::: "memory");
    }
  }
  __syncthreads();
}

typedef const __attribute__((address_space(4))) Params* KPtr;
#if defined(__HIP_DEVICE_COMPILE__)
DI Params KP() { KPtr q = (KPtr)__builtin_amdgcn_kernarg_segment_ptr(); asm volatile("" : "+s"(q)); return *q; }
#else
DI Params KP() { return Params{}; }
#endif

DI void gsync(const Params& p, char* smem) {
  unsigned long long ba = reinterpret_cast<unsigned long long>(p.ws + WS_BAR);
  asm volatile("" : "+s"(ba));
  XcdBarrier b; b.bar = reinterpret_cast<unsigned*>(ba); b.x = xb_xcc_id();
  b.st = reinterpret_cast<volatile LAS unsigned*>((LAS unsigned char*)smem + LDS_BYTES - 16);
  xcd_barrier(b);
}

template <int LAYER>
DI void conv_layer(const Params& p, u16* WIN, u16* wout, int rank, int nranks) {
  constexpr int kind = LAYER % 3, j = LAYER / 3;
  if (kind == 0) {
    conv_job(p.gla_w_in + (size_t)j * 2048 * 6144, 6144, 6144, WIN, 0, rank, nranks);
    conv_job(p.gla_w_a1 + (size_t)j * 2048 * 16, 16, 16, WIN, 6144, rank, nranks);
    for (int id = rank * 512 + opq(threadIdx.x); id < 240 * 256; id += nranks * 512) {
      u32x4 z = {0u, 0u, 0u, 0u};
      reinterpret_cast<u32x4*>(WIN + (size_t)6160 * 2048)[id] = z;
    }
    conv_job(p.gla_w_out + (size_t)j * 2048 * 2048, 2048, 2048, wout, 0, rank, nranks);
  } else if (kind == 1) {
    conv_job(p.hgrn_w_in, 8192, 8192, WIN, 0, rank, nranks);
    conv_job(p.hgrn_w_out, 2048, 2048, wout, 0, rank, nranks);
  } else {
    conv_job(p.diff_w_in, 8192, 8192, WIN, 0, rank, nranks);
    conv_job(p.diff_w_out, 2048, 2048, wout, 0, rank, nranks);
  }
}

template <int LAYER>
DI void do_layer(char* smem, cg::grid_group& grid) {
  const Params p = KP();
  constexpr int layer = LAYER, kind = LAYER % 3, j = LAYER / 3;
  u16* WIN = reinterpret_cast<u16*>(p.ws + WS_WIN);
  u16* WOUT = reinterpret_cast<u16*>(p.ws + ((layer & 1) ? WS_WOUT1 : WS_WOUT));
  u16* WOUT_NEXT = reinterpret_cast<u16*>(p.ws + ((layer & 1) ? WS_WOUT : WS_WOUT1));
  u16* HB = reinterpret_cast<u16*>(p.ws + WS_H);
  u16* PROJ = reinterpret_cast<u16*>(p.ws + WS_PROJ);
  char* PREP_WS = p.ws + WS_PREP;
  char* PREP_OUT = reinterpret_cast<char*>(p.out + OFF_KP);
  if (layer == 0) conv_layer<0>(KP(), WIN, WOUT, blockIdx.x, gridDim.x);
  float* RS = reinterpret_cast<float*>(p.ws + WS_RS);
  u16* XW = reinterpret_cast<u16*>(p.ws + WS_XW);
  if (layer == 0) {
    norm_phase(p.x_prompt, p.x_sample, p.norm_w, HB);
    for (int i = blockIdx.x * 512 + opq(threadIdx.x); i < 4 * MROWS; i += gridDim.x * 512) RS[i] = 0.f;
    grid.sync();
    (void)xcd_barrier_post(reinterpret_cast<unsigned*>(p.ws + WS_BAR), reinterpret_cast<volatile LAS unsigned*>((LAS unsigned char*)smem + LDS_BYTES - 16));
    if (threadIdx.x == 0) {
      const unsigned x = xb_xcc_id();
      const unsigned y = xb_add(reinterpret_cast<unsigned*>(p.ws + WS_BAR) + 8 * x, 1u);
      reinterpret_cast<volatile unsigned*>(smem + LDS_BYTES - 16)[2] = (x << 16) | (y & 0xffffu);
    }
  }
  {
    pg8::EpiProj E; E.O = PROJ; E.ldc = kind == 0 ? GLA_LD : 8192; E.out = p.out; E.mode = kind == 2 ? 1 : 0;
    E.rs = layer == 0 ? nullptr : RS + (layer - 1) * MROWS;
    gemm8(smem, layer == 0 ? HB : XW, WIN, kind == 0 ? GLA_LD : 8192, E);
  }
  gsync(KP(), smem);
  if (kind == 0) {
    prep_phase<0>(KP(), layer, j, PROJ, PREP_WS, smem);
    gsync(KP(), smem);
    seq_phase<0>(KP(), j, PREP_WS, HB, smem);
  } else if (kind == 1) {
    prep_phase<1>(KP(), layer, j, PROJ, PREP_OUT, smem);
    gsync(KP(), smem);
    seq_phase<1>(KP(), j, PREP_OUT, HB, smem);
    if ((int)blockIdx.x >= 128 && gridDim.x > 128) diffprep_cache(KP(), PREP_WS, (int)blockIdx.x - 128, (int)gridDim.x - 128);
    else if (gridDim.x <= 128) diffprep_cache(KP(), PREP_WS, blockIdx.x, gridDim.x);
  } else {
    diffprep_phase(KP(), PROJ, PREP_WS, smem);
    gsync(KP(), smem);
    attn_phase(KP(), PROJ, PREP_WS, HB, smem);
  }
  gsync(KP(), smem);
  if (kind == 0) gate_phase(HB, PROJ, GLA_LD, 4096, p.gla_norm_w + j * 512, 512, 1.f);
  else if (kind == 1) gate_phase(HB, PROJ, 8192, 6144, p.hgrn_norm_w, 2048, 1.f);
  if (kind != 2) gsync(KP(), smem);
  {
    pg8::EpiRes E; E.xp = p.x_prompt; E.xs = p.x_sample; E.out = p.out; E.layer = layer;
    E.wn = p.norm_w + (layer < 3 ? (layer + 1) * DM : 0); E.xw = layer < 3 ? XW : nullptr; E.rs = RS + layer * MROWS;
    gemm8(smem, HB, WOUT, 2048, E);
    if (layer < 3) {
      const int nwg = (MROWS / 256) * (2048 / 256), G = gridDim.x, R = nwg % G;
      if ((int)blockIdx.x >= R) conv_layer<(LAYER + 1) % 4>(KP(), WIN, WOUT_NEXT, (int)blockIdx.x - R, G - R);
    }
  }
  gsync(KP(), smem);
}

__global__ void __launch_bounds__(512) mega(Params p) {
  extern __shared__ __attribute__((aligned(16))) char smem[];
  cg::grid_group grid = cg::this_grid();
  {
    unsigned* bar = reinterpret_cast<unsigned*>(p.ws + WS_BAR);
    if (blockIdx.x == 0) for (int i = threadIdx.x; i < XCD_BAR_WORDS; i += 512) bar[i] = 0u;
    if (threadIdx.x < 4) reinterpret_cast<volatile unsigned*>(smem + LDS_BYTES - 16)[threadIdx.x] = 0u;
    __syncthreads();
  }
  do_layer<0>(smem, grid);
  do_layer<1>(smem, grid);
  do_layer<2>(smem, grid);
  do_layer<3>(smem, grid);
  final_norm_phase(p.out, p.final_norm_w, reinterpret_cast<const float*>(p.ws + WS_RS) + 3 * MROWS);
}

extern "C" void kernel_launch(void* const* d_in, const int* in_sizes, int n_in, void* d_out, int out_size, void* d_ws, size_t ws_size,
                              hipStream_t stream) {
  Params p{};
  p.x_prompt = (const float*)d_in[0]; p.x_sample = (const float*)d_in[1]; p.state_gla = (const float*)d_in[2]; p.state_hgrn = (const float*)d_in[3];
  p.cache_k = (const float*)d_in[4]; p.cache_v = (const float*)d_in[5]; p.norm_w = (const float*)d_in[6]; p.final_norm_w = (const float*)d_in[7];
  p.gla_w_in = (const float*)d_in[8]; p.gla_w_a1 = (const float*)d_in[9]; p.gla_w_a2 = (const float*)d_in[10]; p.gla_b_a = (const float*)d_in[11];
  p.gla_norm_w = (const float*)d_in[12]; p.gla_w_out = (const float*)d_in[13];
  p.hgrn_w_in = (const float*)d_in[14]; p.hgrn_lb = (const float*)d_in[15]; p.hgrn_norm_w = (const float*)d_in[16]; p.hgrn_w_out = (const float*)d_in[17];
  p.diff_w_in = (const float*)d_in[18]; p.diff_lambda = (const float*)d_in[19]; p.diff_subln_w = (const float*)d_in[20]; p.diff_w_out = (const float*)d_in[21];
  p.out = (float*)d_out; p.ws = (char*)d_ws;
  static int grid_blocks = 0;
  if (!grid_blocks) {
    int dev = 0, cus = 0, per_cu = 0;
    (void)hipGetDevice(&dev);
    (void)hipFuncSetAttribute((const void*)mega, hipFuncAttributeMaxDynamicSharedMemorySize, (int)LDS_BYTES);
    (void)hipDeviceGetAttribute(&cus, hipDeviceAttributeMultiprocessorCount, dev);
    (void)hipOccupancyMaxActiveBlocksPerMultiprocessor(&per_cu, mega, 512, LDS_BYTES);
    if (per_cu < 1) per_cu = 1;
    if (per_cu > 1) per_cu = 1;
    grid_blocks = cus * per_cu;
  }
  void* args[] = {&p};
  hipError_t e = hipLaunchCooperativeKernel((void*)mega, dim3(grid_blocks), dim3(512), args, LDS_BYTES, stream);
  if (e != hipSuccess) fprintf(stderr, "cooperative launch failed: %s (grid %d)\n", hipGetErrorString(e), grid_blocks);
}
```

```cpp
#include <hip/hip_runtime.h>
#include <hip/hip_cooperative_groups.h>
#include <cstdio>
namespace cg = cooperative_groups;

typedef unsigned short u16;
typedef unsigned int u32;
using bf16x8 = __attribute__((ext_vector_type(8))) short;
using f32x16 = __attribute__((ext_vector_type(16))) float;
using f32x4 = __attribute__((ext_vector_type(4))) float;
using u32x4 = __attribute__((ext_vector_type(4))) unsigned;
using u32x2 = __attribute__((ext_vector_type(2))) unsigned;

#define DI __device__ __forceinline__
#define MFMA(a, b, c) __builtin_amdgcn_mfma_f32_32x32x16_bf16((a), (b), (c), 0, 0, 0)
#define LAS __attribute__((address_space(3)))

constexpr int MROWS = 16640;
constexpr int PROWS = 16384;
constexpr int DM = 2048;
constexpr size_t OFF_GSP = 34078720;
constexpr size_t OFF_GSS = 38273024;
constexpr size_t OFF_HSP = 46661632;
constexpr size_t OFF_HSS = 47710208;
constexpr size_t OFF_KP = 49807360;
constexpr size_t OFF_VP = 83361792;
constexpr size_t OFF_KS = 116916224;
constexpr size_t OFF_VS = 117440512;
constexpr size_t WS_WIN = 0;
constexpr size_t WS_WOUT = 33554432;
constexpr size_t WS_H = 41943040;
constexpr size_t WS_PROJ = 110100480;
constexpr size_t WS_PREP = 382730240;
constexpr size_t WS_XW = 530874368;
constexpr size_t WS_BAR = 599031808;
constexpr size_t WS_RS = 599048192;
constexpr size_t WS_WOUT1 = 599314432;
constexpr size_t LDS_BYTES = 147456;
constexpr float LAM_INIT = 0.47071302f;
constexpr int GLA_LD = 6400;

struct Params {
  const float* x_prompt; const float* x_sample; const float* state_gla; const float* state_hgrn;
  const float* cache_k; const float* cache_v; const float* norm_w; const float* final_norm_w;
  const float* gla_w_in; const float* gla_w_a1; const float* gla_w_a2; const float* gla_b_a;
  const float* gla_norm_w; const float* gla_w_out;
  const float* hgrn_w_in; const float* hgrn_lb; const float* hgrn_norm_w; const float* hgrn_w_out;
  const float* diff_w_in; const float* diff_lambda; const float* diff_subln_w; const float* diff_w_out;
  float* out; char* ws;
};

typedef __bf16 bf16v2 __attribute__((ext_vector_type(2)));
typedef float f32v2 __attribute__((ext_vector_type(2)));
DI u32 pack2(float a, float b) { f32v2 v = {a, b}; return __builtin_bit_cast(u32, __builtin_convertvector(v, bf16v2)); }
DI u16 f2bf(float x) { return (u16)(pack2(x, 0.f) & 0xffffu); }
DI float bf2f(u16 b) { return __uint_as_float(((u32)b) << 16); }
DI float bflo(u32 p) { return __uint_as_float(p << 16); }
DI float bfhi(u32 p) { return __uint_as_float(p & 0xffff0000u); }
DI bf16x8 ld16(const u16* p) { return *reinterpret_cast<const bf16x8*>(p); }
DI bf16x8 ld8x2(const u16* p0, const u16* p1) {
  u32x2 a = *reinterpret_cast<const u32x2*>(p0); u32x2 b = *reinterpret_cast<const u32x2*>(p1);
  u32x4 r = {a.x, a.y, b.x, b.y}; return __builtin_bit_cast(bf16x8, r);
}
DI int opq(int x) { asm volatile("" : "+v"(x)); return x; }
DI int crow(int reg, int hh) { return (reg & 3) + 8 * (reg >> 2) + 4 * hh; }
template <int S> DI bf16x8 packacc(const f32x16& x) {
  u32x4 r = {pack2(x[8 * S], x[8 * S + 1]), pack2(x[8 * S + 2], x[8 * S + 3]), pack2(x[8 * S + 4], x[8 * S + 5]), pack2(x[8 * S + 6], x[8 * S + 7])};
  return __builtin_bit_cast(bf16x8, r);
}
DI float wave_sum(float v) {
#pragma unroll
  for (int o = 32; o > 0; o >>= 1) v += __shfl_xor(v, o);
  return v;
}
DI f32x16 zero16() { f32x16 z;
#pragma unroll
  for (int i = 0; i < 16; ++i) z[i] = 0.f;
  return z; }

DI void conv_job(const float* W, int ldw, int ncols, u16* Wt, int drow0, int rank, int nranks) {
  const int tid = opq(threadIdx.x), lane = tid & 63, wv = tid >> 6;
  const int ntn = (ncols + 63) >> 6;
  const int ntiles = 64 * ntn;
  for (int tile = rank * 8 + wv; tile < ntiles; tile += nranks * 8) {
    const int tn = tile % ntn, tk = tile / ntn;
    const int n = tn * 64 + lane, k0 = tk * 32;
    if (n < ncols) {
      const float* src = W + (size_t)k0 * ldw + n;
      float v[32];
#pragma unroll
      for (int i = 0; i < 32; ++i) v[i] = __builtin_nontemporal_load(src + (size_t)i * ldw);
      u32x4* dst = reinterpret_cast<u32x4*>(Wt + (size_t)(drow0 + n) * 2048 + k0);
#pragma unroll
      for (int i = 0; i < 4; ++i) {
        u32x4 o = {pack2(v[8 * i], v[8 * i + 1]), pack2(v[8 * i + 2], v[8 * i + 3]), pack2(v[8 * i + 4], v[8 * i + 5]), pack2(v[8 * i + 6], v[8 * i + 7])};
        dst[i] = o;
      }
    }
  }
}

DI void norm_phase(const float* xp, const float* xs, const float* w, u16* h) {
  const int tid = opq(threadIdx.x); const int lane = tid & 63, wv = tid >> 6;
  for (int row = blockIdx.x * 8 + wv; row < MROWS; row += gridDim.x * 8) {
    const float* src = row < PROWS ? xp + (size_t)row * DM : xs + (size_t)(row - PROWS) * DM;
    float4 v[8]; float ss = 0.f;
#pragma unroll
    for (int i = 0; i < 8; ++i) { const f32x4 t4 = __builtin_nontemporal_load(reinterpret_cast<const f32x4*>(src) + i * 64 + lane); v[i] = make_float4(t4[0], t4[1], t4[2], t4[3]); ss += v[i].x * v[i].x + v[i].y * v[i].y + v[i].z * v[i].z + v[i].w * v[i].w; }
    ss = wave_sum(ss);
    const float r = rsqrtf(ss * (1.f / 2048.f) + 1e-6f);
    u32x2* dst = reinterpret_cast<u32x2*>(h + (size_t)row * DM);
#pragma unroll
    for (int i = 0; i < 8; ++i) {
      const float4 ww = reinterpret_cast<const float4*>(w)[i * 64 + lane];
      u32x2 o = {pack2(v[i].x * r * ww.x, v[i].y * r * ww.y), pack2(v[i].z * r * ww.z, v[i].w * r * ww.w)};
      dst[i * 64 + lane] = o;
    }
  }
}

DI void final_norm_phase(float* y, const float* w, const float* rs) {
  const int tid = opq(threadIdx.x); const int lane = tid & 63, wv = tid >> 6;
  for (int row = blockIdx.x * 8 + wv; row < MROWS; row += gridDim.x * 8) {
    float4* src = reinterpret_cast<float4*>(y + (size_t)row * DM);
    const float r = rsqrtf(rs[row] * (1.f / 2048.f) + 1e-6f);
#pragma unroll
    for (int i = 0; i < 8; ++i) {
      const float4 v = src[i * 64 + lane];
      const float4 ww = reinterpret_cast<const float4*>(w)[i * 64 + lane];
      f32x4 o = {v.x * r * ww.x, v.y * r * ww.y, v.z * r * ww.z, v.w * r * ww.w};
      __builtin_nontemporal_store(o, reinterpret_cast<f32x4*>(src) + i * 64 + lane);
    }
  }
}

namespace pg8 {
constexpr int BM = 256, BK = 64, HALF = 128, HTB = HALF * BK * 2, NXCD = 8, WGM = 8;
DI int lds_byte(int r, int c) { const int st = (r >> 4) * 2 + (c >> 5), rr = r & 15, cc = c & 31, ob = rr * 64 + cc * 2; return st * 1024 + (ob ^ (((ob >> 9) & 1) << 5)); }
DI void stage_rc(int b, int& R, int& C) { const int st = b / 1024, sb = b % 1024, swz = sb ^ (((sb >> 9) & 1) << 5); R = (st >> 1) * 16 + swz / 64; C = (st & 1) * 32 + (swz % 64) / 2; }
DI int perm32(int rho) { const int n = rho >> 4, i = rho & 15; return 8 * (i >> 2) + 4 * n + (i & 3); }
struct Unit { int pm, pn; };
struct Gemm { const u16* A; const u16* Bt; int M, N, K; };
struct StaticOrder {
  int nM, nN, nwg, G, c;
  DI void init(int M, int N, int G_, int c_) { nM = M / BM; nN = N / BM; nwg = nM * nN; G = G_; c = c_; }
  DI bool next(int i, Unit& u) const {
    const long L = (long)i * G + c; if (L >= nwg) return false;
    int wgid = (int)L; { const int q = nwg / NXCD, r = nwg % NXCD, xcd = wgid % NXCD, off = wgid / NXCD; wgid = (xcd < r ? xcd * (q + 1) : r * (q + 1) + (xcd - r) * q) + off; }
    const int nig = WGM * nN, gid = wgid / nig, fm = gid * WGM, gsz = (nM - fm) < WGM ? (nM - fm) : WGM;
    u.pm = fm + ((wgid % nig) % gsz); u.pn = (wgid % nig) / gsz; return true;
  }
};

template <class Epi>
DI void gemm_phase(LAS unsigned char* lds, const Gemm g, const StaticOrder& S, const Epi& E) {
  const int tid = opq(threadIdx.x), wid = __builtin_amdgcn_readfirstlane(tid >> 6), lane = tid & 63, wr = wid >> 2, wc = wid & 3, fr = lane & 15, fq = lane >> 4;
  const int K = g.K, nt = K / BK;
  unsigned voffA[2], voffB[2];
#pragma unroll
  for (int i = 0; i < 2; ++i) { int R, C; stage_rc(tid * 16 + i * 8192, R, C); const int Rb = Epi::PERM ? ((R & ~31) + perm32(R & 31)) : R;
    voffA[i] = (unsigned)(R * K + C) * 2u; voffB[i] = (unsigned)(Rb * K + C) * 2u; }
  const size_t kstep = (size_t)(BK * 2);
  const size_t hstep = (size_t)HALF * K * 2;
  const size_t tstep = 2 * hstep;
  const unsigned ldsw = (unsigned)wid * 1024u;
  const int aoff = lds_byte(wr * 64 + fr, fq * 8), boff = lds_byte(wc * 32 + fr, fq * 8);
#define PG8_SA(b, h) (((b) * 2 + (h)) * HTB)
#define PG8_SB(b, h) ((4 + (b) * 2 + (h)) * HTB)
#define PG8_STAGE(bufoff, gbase, voff) do { _Pragma("unroll") for (int _i = 0; _i < 2; ++_i) \
    __builtin_amdgcn_global_load_lds((const unsigned*)((const char*)(gbase) + (voff)[_i]), (LAS unsigned*)(lds + (bufoff) + ldsw + _i * 8192), 16, 0, 0); } while (0)
#define PG8_LDA(dst, b, h) do { _Pragma("unroll") for (int m = 0; m < 4; ++m) _Pragma("unroll") for (int k = 0; k < 2; ++k) dst[m][k] = *(const LAS bf16x8*)(lds + PG8_SA(b, h) + aoff + m * 2048 + k * 1024); } while (0)
#define PG8_LDB(dst, b, h) do { _Pragma("unroll") for (int n = 0; n < 2; ++n) _Pragma("unroll") for (int k = 0; k < 2; ++k) dst[n][k] = *(const LAS bf16x8*)(lds + PG8_SB(b, h) + boff + n * 2048 + k * 1024); } while (0)
#define PG8_MMA(ai, bj, At, Bt) do { __builtin_amdgcn_s_setprio(1); _Pragma("unroll") for (int m = 0; m < 4; ++m) _Pragma("unroll") for (int n = 0; n < 2; ++n) _Pragma("unroll") for (int k = 0; k < 2; ++k) \
    acc[ai][bj][m][n] = __builtin_amdgcn_mfma_f32_16x16x32_bf16(Bt[n][k], At[m][k], acc[ai][bj][m][n], 0, 0, 0); __builtin_amdgcn_s_setprio(0); } while (0)
#define PG8_WAIT_V(n) asm volatile("s_waitcnt vmcnt(" #n ")" ::: "memory")
#define PG8_WAIT_L(n) asm volatile("s_waitcnt lgkmcnt(" #n ")" ::: "memory")
#define PG8_BAR __builtin_amdgcn_s_barrier()
#define PG8_SCHED __builtin_amdgcn_sched_barrier(0)
  Unit cur, nxt; int ui = 0;
  if (!S.next(0, cur)) return;
  f32x4 acc[2][2][4][2];
#pragma unroll
  for (int a = 0; a < 2; ++a)
#pragma unroll
    for (int b = 0; b < 2; ++b)
#pragma unroll
      for (int m = 0; m < 4; ++m)
#pragma unroll
        for (int n = 0; n < 2; ++n) acc[a][b][m][n] = (f32x4){0.f, 0.f, 0.f, 0.f};
  bf16x8 At[4][2], B0[2][2], B1[2][2];
  const char* cA = (const char*)g.A + (size_t)cur.pm * tstep; const char* cB = (const char*)g.Bt + (size_t)cur.pn * tstep;
  PG8_STAGE(PG8_SB(0, 0), cB, voffB); PG8_STAGE(PG8_SA(0, 0), cA, voffA); PG8_STAGE(PG8_SB(0, 1), cB + hstep, voffB); PG8_STAGE(PG8_SA(0, 1), cA + hstep, voffA);
  if (wr == 1) PG8_BAR;
  PG8_WAIT_V(4); PG8_BAR;
  PG8_STAGE(PG8_SB(1, 0), cB + kstep, voffB); PG8_STAGE(PG8_SA(1, 0), cA + kstep, voffA); PG8_STAGE(PG8_SB(1, 1), cB + hstep + kstep, voffB);
  PG8_WAIT_V(6); PG8_BAR;
  for (;;) {
    const bool has_next = S.next(ui + 1, nxt);
    const char* nA = has_next ? (const char*)g.A + (size_t)nxt.pm * tstep : cA; const char* nB = has_next ? (const char*)g.Bt + (size_t)nxt.pn * tstep : cB;
    for (int t = 0; t < nt; t += 2) {
      const bool last = (t == nt - 2);
      const char* a1 = cA + (size_t)(t + 1) * kstep;
      const char* a2 = last ? nA : cA + (size_t)(t + 2) * kstep; const char* b2 = last ? nB : cB + (size_t)(t + 2) * kstep;
      const char* a3 = a2 + kstep; const char* b3 = b2 + kstep;
      PG8_LDB(B0, 0, 0); PG8_SCHED; PG8_LDA(At, 0, 0); PG8_STAGE(PG8_SA(1, 1), a1 + hstep, voffA);
      PG8_WAIT_L(8); PG8_BAR; PG8_WAIT_L(0); PG8_MMA(0, 0, At, B0); PG8_BAR; PG8_SCHED;
      PG8_LDB(B1, 0, 1); PG8_STAGE(PG8_SB(0, 0), b2, voffB);
      PG8_BAR; PG8_WAIT_L(0); PG8_MMA(0, 1, At, B1); PG8_BAR;
      PG8_LDA(At, 0, 1); PG8_STAGE(PG8_SA(0, 0), a2, voffA);
      PG8_BAR; PG8_WAIT_L(0); PG8_MMA(1, 0, At, B0); PG8_BAR; PG8_SCHED;
      PG8_STAGE(PG8_SB(0, 1), b2 + hstep, voffB);
      PG8_WAIT_V(6); PG8_BAR; PG8_MMA(1, 1, At, B1); PG8_BAR;
      PG8_LDB(B0, 1, 0); PG8_SCHED; PG8_LDA(At, 1, 0); PG8_STAGE(PG8_SA(0, 1), a2 + hstep, voffA);
      PG8_WAIT_L(8); PG8_BAR; PG8_WAIT_L(0); PG8_MMA(0, 0, At, B0); PG8_BAR; PG8_SCHED;
      PG8_LDB(B1, 1, 1); PG8_STAGE(PG8_SB(1, 0), b3, voffB);
      PG8_BAR; PG8_WAIT_L(0); PG8_MMA(0, 1, At, B1); PG8_BAR;
      PG8_LDA(At, 1, 1); PG8_STAGE(PG8_SA(1, 0), a3, voffA);
      PG8_BAR; PG8_WAIT_L(0); PG8_MMA(1, 0, At, B0); PG8_BAR; PG8_SCHED;
      PG8_STAGE(PG8_SB(1, 1), b3 + hstep, voffB);
      PG8_WAIT_V(6); PG8_BAR; PG8_MMA(1, 1, At, B1); PG8_BAR;
    }
    E(acc, cur, wr, wc, fr, fq);
    if (!has_next) break;
#pragma unroll
    for (int a = 0; a < 2; ++a)
#pragma unroll
      for (int b = 0; b < 2; ++b)
#pragma unroll
        for (int m = 0; m < 4; ++m)
#pragma unroll
          for (int n = 0; n < 2; ++n) acc[a][b][m][n] = (f32x4){0.f, 0.f, 0.f, 0.f};
    cur = nxt; cA = nA; cB = nB; ++ui;
  }
  PG8_WAIT_V(0);
  if (wr == 0) PG8_BAR;
  PG8_BAR;
#undef PG8_SA
#undef PG8_SB
#undef PG8_STAGE
#undef PG8_LDA
#undef PG8_LDB
#undef PG8_MMA
#undef PG8_WAIT_V
#undef PG8_WAIT_L
#undef PG8_BAR
#undef PG8_SCHED
}

struct EpiProj {
  static constexpr bool PERM = true;
  u16* O; int ldc; float* out; int mode; const float* rs;
  DI void operator()(const f32x4 (&acc)[2][2][4][2], const Unit& u, int wr, int wc, int fr, int fq) const {
    const int row0 = u.pm * BM + wr * 64 + fr, colt = u.pn * BM, col0 = colt + wc * 32 + 8 * fq;
    const bool kv = (mode == 1) && colt >= 2048 && colt < 6144;
    const int sec = colt >= 4096 ? 1 : 0;
#pragma unroll
    for (int ai = 0; ai < 2; ++ai)
#pragma unroll
      for (int m = 0; m < 4; ++m) {
        const int row = row0 + ai * HALF + m * 16;
        u16* rowp = O + (size_t)row * ldc + col0;
        const float rr = rs ? rsqrtf(rs[row] * (1.f / 2048.f) + 1e-6f) : 1.f;
#pragma unroll
        for (int bj = 0; bj < 2; ++bj) {
          const f32x4 v0 = acc[ai][bj][m][0] * rr, v1 = acc[ai][bj][m][1] * rr;
          u32x4 w = {pack2(v0[0], v0[1]), pack2(v0[2], v0[3]), pack2(v1[0], v1[1]), pack2(v1[2], v1[3])};
          *reinterpret_cast<u32x4*>(rowp + bj * HALF) = w;
          if (kv) {
            const int c2 = col0 + bj * HALF - 2048 - sec * 2048;
            float* dst = row < PROWS ? out + (sec ? OFF_VP : OFF_KP) + (size_t)row * DM + c2 : out + (sec ? OFF_VS : OFF_KS) + (size_t)(row - PROWS) * DM + c2;
            __builtin_nontemporal_store(v0, reinterpret_cast<f32x4*>(dst)); __builtin_nontemporal_store(v1, reinterpret_cast<f32x4*>(dst + 4));
          }
        }
      }
  }
};
struct EpiRes {
  static constexpr bool PERM = true;
  const float* xp; const float* xs; float* out; int layer; const float* wn; u16* xw; float* rs;
  DI void operator()(const f32x4 (&acc)[2][2][4][2], const Unit& u, int wr, int wc, int fr, int fq) const {
    const int row0 = u.pm * BM + wr * 64 + fr, col0 = u.pn * BM + wc * 32 + 8 * fq;
    f32x4 wv[2][2];
#pragma unroll
    for (int bj = 0; bj < 2; ++bj)
#pragma unroll
      for (int n = 0; n < 2; ++n) wv[bj][n] = xw ? *reinterpret_cast<const f32x4*>(wn + col0 + bj * HALF + n * 4) : (f32x4){0.f, 0.f, 0.f, 0.f};
#pragma unroll
    for (int ai = 0; ai < 2; ++ai)
#pragma unroll
      for (int m = 0; m < 4; ++m) {
        const int row = row0 + ai * HALF + m * 16;
        float* dst = out + (size_t)row * DM + col0;
        const float* src = layer == 0 ? (row < PROWS ? xp + (size_t)row * DM + col0 : xs + (size_t)(row - PROWS) * DM + col0) : dst;
        float ss = 0.f;
#pragma unroll
        for (int bj = 0; bj < 2; ++bj) {
          const f32x4 x0 = *reinterpret_cast<const f32x4*>(src + bj * HALF), x1 = *reinterpret_cast<const f32x4*>(src + bj * HALF + 4);
          const f32x4 n0 = x0 + acc[ai][bj][m][0], n1 = x1 + acc[ai][bj][m][1];
          *reinterpret_cast<f32x4*>(dst + bj * HALF) = n0; *reinterpret_cast<f32x4*>(dst + bj * HALF + 4) = n1;
          ss += n0[0] * n0[0] + n0[1] * n0[1] + n0[2] * n0[2] + n0[3] * n0[3] + n1[0] * n1[0] + n1[1] * n1[1] + n1[2] * n1[2] + n1[3] * n1[3];
          if (xw) {
            const f32x4 h0 = n0 * wv[bj][0], h1 = n1 * wv[bj][1];
            u32x4 pk = {pack2(h0[0], h0[1]), pack2(h0[2], h0[3]), pack2(h1[0], h1[1]), pack2(h1[2], h1[3])};
            *reinterpret_cast<u32x4*>(xw + (size_t)row * DM + col0 + bj * HALF) = pk;
          }
        }
        ss += __shfl_xor(ss, 16); ss += __shfl_xor(ss, 32);
        if (fq == 0) atomicAdd(rs + row, ss);
      }
  }
};
}

template <class Epi>
DI void gemm8(char* smem, const u16* A, const u16* Bt, int N, const Epi& E) {
  pg8::Gemm g; g.A = A; g.Bt = Bt; g.M = MROWS; g.N = N; g.K = 2048;
  pg8::StaticOrder S; S.init(MROWS, N, gridDim.x, blockIdx.x);
  pg8::gemm_phase<Epi>((LAS unsigned char*)smem, g, S, E);
}

template <int KIND> struct RC {
  static constexpr int H = KIND == 0 ? 4 : 16;
  static constexpr int KH = KIND == 0 ? 256 : 128;
  static constexpr int VH = KIND == 0 ? 512 : 128;
  static constexpr int HPB = 256 / KH;
  static constexpr int LD = KIND == 0 ? GLA_LD : 8192;
  static constexpr int NIT = 264 * H;
  static constexpr int VOFF = KIND == 0 ? 2048 : 4096;
  static constexpr size_t SZQ = (size_t)NIT * 64 * KH;
  static constexpr size_t SZV = (size_t)NIT * VH * 64;
};

template <int KIND>
DI void prep_phase(const Params& p, int layer, int j, const u16* proj, char* prep, char* smem) {
  using C = RC<KIND>;
  constexpr int H = C::H, KH = C::KH, VH = C::VH, HPB = C::HPB, LD = C::LD, KTH = KH / 32;
  constexpr float L2E = 1.4426950408889634f, LN2 = 0.6931471805599453f;
  u16* QF = reinterpret_cast<u16*>(prep);
  u16* KF = QF + C::SZQ;
  u16* VF = KF + C::SZQ;
  u16* AF = VF + C::SZV;
  float* DL = reinterpret_cast<float*>(AF + (size_t)C::NIT * 4096);
  const int tid = opq(threadIdx.x), half = tid >> 8, c = tid & 255, lane = tid & 63, wvl = (tid >> 6) & 3, l31 = lane & 31, hh = lane >> 5;
  u16* qs = reinterpret_cast<u16*>(smem) + half * (2 * 64 * 264 + 64 * 16);
  u16* ks = qs + 64 * 264;
  u16* as = ks + 64 * 264;
  constexpr int HG = H / HPB;
  const int nblk = 264 * HG;
  for (int bi = blockIdx.x * 2 + half; bi < nblk; bi += gridDim.x * 2) {
    const int cgk = bi / HG, hg = bi - cgk * HG;
    const int nvalid = cgk < 256 ? 64 : 32;
    const size_t row0 = cgk < 256 ? (size_t)cgk * 64 : (size_t)PROWS + (size_t)(cgk - 256) * 32;
    const int head = hg * HPB + c / KH, kk = c % KH;
    const int item = cgk * H + head;
    float w2[16]; float ba = 0.f, lb = 0.f;
    if (KIND == 0) {
#pragma unroll
      for (int r = 0; r < 16; ++r) w2[r] = p.gla_w_a2[(size_t)j * 16 * 1024 + r * 1024 + head * 256 + kk];
      ba = p.gla_b_a[j * 1024 + head * 256 + kk];
    } else {
#pragma unroll
      for (int r = 0; r < 16; ++r) w2[r] = 0.f;
      const int ch = head * 128 + kk;
      float l0 = p.hgrn_lb[ch], l1 = p.hgrn_lb[2048 + ch], l2 = p.hgrn_lb[4096 + ch], l3 = p.hgrn_lb[6144 + ch];
      float mx = fmaxf(fmaxf(l0, l1), fmaxf(l2, l3));
      float e0 = expf(l0 - mx), e1 = expf(l1 - mx), e2 = expf(l2 - mx), e3 = expf(l3 - mx);
      float inv = 1.f / (e0 + e1 + e2 + e3);
      float acc = 0.f;
      if (layer >= 1) acc += e1;
      if (layer >= 2) acc += e2;
      if (layer >= 3) acc += e3;
      lb = acc * inv;
    }
    __syncthreads();
    {
      const u16* qsrc = proj + row0 * LD + hg * 256;
      const u16* ksrc = qsrc + (KIND == 0 ? 1024 : 2048);
#pragma unroll
      for (int i = 0; i < 8; ++i) {
        const int id = c + 256 * i, t = id >> 5, ch = id & 31;
        u32x4 vq = {0u, 0u, 0u, 0u}, vk = {0u, 0u, 0u, 0u};
        if (t < nvalid) {
          vq = *reinterpret_cast<const u32x4*>(qsrc + (size_t)t * LD + ch * 8);
          vk = *reinterpret_cast<const u32x4*>(ksrc + (size_t)t * LD + ch * 8);
        }
        *reinterpret_cast<u32x4*>(qs + t * 264 + ch * 8) = vq;
        *reinterpret_cast<u32x4*>(ks + t * 264 + ch * 8) = vk;
      }
      if (KIND == 0 && c < 128) {
        const int t = c >> 1, part = c & 1;
        u32x4 va = {0u, 0u, 0u, 0u};
        if (t < nvalid) va = *reinterpret_cast<const u32x4*>(proj + (row0 + t) * LD + 6144 + part * 8);
        *reinterpret_cast<u32x4*>(as + t * 16 + part * 8) = va;
      }
    }
    __syncthreads();
    float b = 0.f;
    {
      const int kt = kk >> 5, kl = kk & 31;
      u16* kfb = KF + (size_t)item * 64 * KH + ((size_t)(kt * 4) * 64 + kl) * 8;
#pragma unroll 2
      for (int t8 = 0; t8 < 8; ++t8) {
        u32 pk[4];
#pragma unroll
        for (int e = 0; e < 4; ++e) {
          u16 kb[2];
#pragma unroll
          for (int q = 0; q < 2; ++q) {
            const int t = t8 * 8 + 2 * e + q;
            const float qr = bf2f(qs[t * 264 + c]), kr = bf2f(ks[t * 264 + c]);
            float qv, kv, g;
            if (KIND == 0) {
              qv = qr * 0.0625f; kv = kr;
              const u32x4 a0 = *reinterpret_cast<const u32x4*>(as + t * 16);
              const u32x4 a1 = *reinterpret_cast<const u32x4*>(as + t * 16 + 8);
              float x = ba;
              x += bflo(a0.x) * w2[0] + bfhi(a0.x) * w2[1] + bflo(a0.y) * w2[2] + bfhi(a0.y) * w2[3];
              x += bflo(a0.z) * w2[4] + bfhi(a0.z) * w2[5] + bflo(a0.w) * w2[6] + bfhi(a0.w) * w2[7];
              x += bflo(a1.x) * w2[8] + bfhi(a1.x) * w2[9] + bflo(a1.y) * w2[10] + bfhi(a1.y) * w2[11];
              x += bflo(a1.z) * w2[12] + bfhi(a1.z) * w2[13] + bflo(a1.w) * w2[14] + bfhi(a1.w) * w2[15];
              const float ex = __builtin_amdgcn_exp2f(-fabsf(x) * L2E);
              g = (fminf(x, 0.f) - __builtin_amdgcn_logf(1.f + ex) * LN2) * 0.0625f;
            } else {
              qv = qr / (1.f + __builtin_amdgcn_exp2f(-qr * L2E)) * 0.08838834764831845f;
              const float sg = 1.f / (1.f + __builtin_amdgcn_exp2f(-kr * L2E));
              const float fg = lb + (1.f - lb) * sg;
              kv = 1.f - fg;
              g = __builtin_amdgcn_logf(fg) * LN2;
            }
            if (t >= nvalid) { qv = 0.f; kv = 0.f; g = 0.f; }
            b += g;
            qs[t * 264 + c] = f2bf(qv * __builtin_amdgcn_exp2f(b * L2E));
            kb[q] = f2bf(kv * __builtin_amdgcn_exp2f(fminf(-b, 80.f) * L2E));
            ks[t * 264 + c] = kb[q];
          }
          pk[e] = (u32)kb[0] | ((u32)kb[1] << 16);
        }
        u32x4 o = {pk[0], pk[1], pk[2], pk[3]};
        *reinterpret_cast<u32x4*>(kfb + ((size_t)((t8 >> 1) * 64 + (t8 & 1) * 32)) * 8) = o;
      }
    }
    DL[(size_t)item * KH + kk] = __builtin_amdgcn_exp2f(b * L2E);
    __syncthreads();
    for (int jb = wvl; jb < HPB * 4; jb += 4) {
      const int hl = jb >> 2, tr = (jb >> 1) & 1, tc = jb & 1;
      f32x16 acc = zero16();
      if (!(tr == 0 && tc == 1)) {
#pragma unroll
        for (int s = 0; s < KH / 16; ++s) {
          bf16x8 a = ld16(qs + (tr * 32 + l31) * 264 + hl * KH + s * 16 + hh * 8);
          bf16x8 bb = ld16(ks + (tc * 32 + l31) * 264 + hl * KH + s * 16 + hh * 8);
          acc = MFMA(a, bb, acc);
        }
      }
      u16* am = AF + (size_t)(cgk * H + hg * HPB + hl) * 4096;
      const int scol = tc * 32 + l31;
      const int s16 = scol >> 4, hs = (scol >> 3) & 1, jj = scol & 7;
#pragma unroll
      for (int reg = 0; reg < 16; ++reg) {
        const int tl = crow(reg, hh), t = tr * 32 + tl;
        am[((tr * 4 + s16) * 64 + hs * 32 + tl) * 8 + jj] = f2bf(scol <= t ? acc[reg] : 0.f);
      }
    }
#pragma unroll
    for (int i = 0; i < 8; ++i) {
      const int f = c + 256 * i, fl = f & 63, fi = f >> 6;
      const int mt = fi & 1, s = (fi >> 1) & 1, ktg = fi >> 2;
      const int hl = ktg / KTH, kt = ktg % KTH;
      const int t = mt * 32 + (fl & 31), fh = fl >> 5;
      const u16* src = qs + t * 264 + ktg * 32 + 16 * s + 4 * fh;
      const bf16x8 v = ld8x2(src, src + 8);
      *reinterpret_cast<bf16x8*>(QF + (size_t)(cgk * H + hg * HPB + hl) * 64 * KH + ((size_t)(((kt * 2 + s) * 2 + mt) * 64 + fl)) * 8) = v;
    }
#pragma unroll 1
    for (int pc = 0; pc < HPB * VH / 256; ++pc) {
      __syncthreads();
      {
        const u16* vsrc = proj + row0 * LD + C::VOFF + (hg * HPB) * VH + pc * 256;
#pragma unroll
        for (int i = 0; i < 8; ++i) {
          const int id = c + 256 * i, t = id >> 5, ch = id & 31;
          u32x4 vv = {0u, 0u, 0u, 0u};
          if (t < nvalid) vv = *reinterpret_cast<const u32x4*>(vsrc + (size_t)t * LD + ch * 8);
          *reinterpret_cast<u32x4*>(qs + t * 264 + ch * 8) = vv;
        }
      }
      __syncthreads();
      const int cv = pc * 256 + c;
      const int hl = cv / VH, v = cv % VH;
      u16* dst = VF + (size_t)(cgk * H + hg * HPB + hl) * VH * 64 + ((size_t)((v >> 5) * 4) * 64 + (v & 31)) * 8;
#pragma unroll
      for (int t8 = 0; t8 < 8; ++t8) {
        u32 pk[4];
#pragma unroll
        for (int e = 0; e < 4; ++e) {
          const int t = t8 * 8 + 2 * e;
          pk[e] = (u32)qs[t * 264 + c] | ((u32)qs[(t + 1) * 264 + c] << 16);
        }
        u32x4 o = {pk[0], pk[1], pk[2], pk[3]};
        *reinterpret_cast<u32x4*>(dst + ((size_t)((t8 >> 1) * 64 + (t8 & 1) * 32)) * 8) = o;
      }
    }
  }
}

template <int NA_> struct SeqOps { bf16x8 q[2][2]; bf16x8 k[4]; bf16x8 v[4]; bf16x8 a[NA_]; float4 dl[4]; };

template <int KIND>
DI void seq_phase(const Params& p, int j, const char* prep, u16* obuf, char* smem) {
  using C = RC<KIND>;
  constexpr int H = C::H, KH = C::KH, VH = C::VH, WPI = KH / 32, IPB = 8 / WPI, NA = 8 / WPI, NVS = VH / 32, NV = 32 / WPI;
  const u16* QF = reinterpret_cast<const u16*>(prep);
  const u16* KF = QF + C::SZQ;
  const u16* VF = KF + C::SZQ;
  const u16* AF = VF + C::SZV;
  const float* DL = reinterpret_cast<const float*>(AF + (size_t)C::NIT * 4096);
  float* red = reinterpret_cast<float*>(smem);
  const int tid = opq(threadIdx.x), lane = tid & 63, wv = __builtin_amdgcn_readfirstlane(tid >> 6), l31 = lane & 31, hh = lane >> 5;
  const int grp = wv / WPI, wg = wv % WPI, kt = wg;
  constexpr int nitems = 12 * H * NVS, nbitems = nitems / IPB;
  constexpr size_t SSZ = (size_t)H * KH * VH;
  int cnt = 0;
  for (int bitem = blockIdx.x; bitem < nbitems; bitem += gridDim.x) {
    int bsel = bitem;
    {
      constexpr int PER_BH = NVS / IPB, NBH = 4 * H, NPB = NBH * PER_BH;
      if (bitem < NPB) { const int x = bitem & 7, i = bitem >> 3; bsel = (x * (NBH / 8) + i / PER_BH) * PER_BH + i % PER_BH; }
    }
    const int it = bsel * IPB + grp;
    const int seq = it / (H * NVS), rem = it % (H * NVS), head = rem / NVS, vs = rem % NVS;
    const size_t sbase = (size_t)head * KH * VH + (size_t)(kt * 32) * VH + vs * 32 + l31;
    float* st_out;
    if (KIND == 0) st_out = seq < 4 ? p.out + OFF_GSP + (size_t)(j * 4 + seq) * SSZ : p.out + OFF_GSS + (size_t)(j * 8 + seq - 4) * SSZ;
    else st_out = seq < 4 ? p.out + OFF_HSP + (size_t)seq * SSZ : p.out + OFF_HSS + (size_t)(seq - 4) * SSZ;
    f32x16 S;
    if (seq >= 4) {
      const float* st_in = (KIND == 0 ? p.state_gla + (size_t)j * 8 * SSZ : p.state_hgrn) + (size_t)(seq - 4) * SSZ;
#pragma unroll
      for (int reg = 0; reg < 16; ++reg) S[reg] = st_in[sbase + (size_t)crow(reg, hh) * VH];
    } else {
      S = zero16();
    }
    const int nch = seq < 4 ? 64 : 1;
    const int cg0 = seq < 4 ? seq * 64 : 256 + seq - 4;
    const int nvalid = seq < 4 ? 64 : 32;
    SeqOps<NA> cur, nxt;
    auto load_ops = [&](SeqOps<NA>& o, int cgk) {
      const size_t item = (size_t)cgk * H + head;
      const u16* qb = QF + item * 64 * KH + (size_t)(kt * 4) * 512 + lane * 8;
#pragma unroll
      for (int s = 0; s < 2; ++s)
#pragma unroll
        for (int mt = 0; mt < 2; ++mt) o.q[s][mt] = ld16(qb + (s * 2 + mt) * 512);
      const u16* kb = KF + item * 64 * KH + (size_t)(kt * 4) * 512 + lane * 8;
#pragma unroll
      for (int s16 = 0; s16 < 4; ++s16) o.k[s16] = ld16(kb + s16 * 512);
      const u16* vb = VF + item * VH * 64 + (size_t)(vs * 4) * 512 + lane * 8;
#pragma unroll
      for (int s16 = 0; s16 < 4; ++s16) o.v[s16] = ld16(vb + s16 * 512);
#pragma unroll
      for (int i = 0; i < NA; ++i) o.a[i] = ld16(AF + item * 4096 + (size_t)(wg * NA + i) * 512 + lane * 8);
      const float* db = DL + item * KH + kt * 32 + 4 * hh;
#pragma unroll
      for (int g4 = 0; g4 < 4; ++g4) o.dl[g4] = *reinterpret_cast<const float4*>(db + 8 * g4);
    };
    load_ops(cur, cg0);
    constexpr bool DEFER = true;
    u32 osum[NV / 2];
    auto store_o = [&](size_t prow0) {
#pragma unroll
      for (int i = 0; i < NV; ++i) {
        const int vec = wg * NV + i;
        const int t = (vec >> 4) * 32 + crow(vec & 15, hh);
        if (t < nvalid) obuf[(prow0 + t) * DM + head * VH + vs * 32 + l31] = (u16)((i & 1) ? (osum[i >> 1] >> 16) : (osum[i >> 1] & 0xffffu));
      }
    };
    for (int ch = 0; ch < nch; ++ch) {
      if (DEFER && ch > 0) store_o((size_t)(cg0 + ch - 1) * 64);
      if (ch + 1 < nch) load_ops(nxt, cg0 + ch + 1);
      const size_t row0 = seq < 4 ? (size_t)(cg0 + ch) * 64 : (size_t)PROWS + (size_t)(seq - 4) * 32;
      f32x16 O[2]; O[0] = zero16(); O[1] = zero16();
      {
        const bf16x8 b0 = packacc<0>(S), b1 = packacc<1>(S);
        O[0] = MFMA(cur.q[0][0], b0, O[0]);
        O[1] = MFMA(cur.q[0][1], b0, O[1]);
        O[0] = MFMA(cur.q[1][0], b1, O[0]);
        O[1] = MFMA(cur.q[1][1], b1, O[1]);
      }
#pragma unroll
      for (int i = 0; i < NA; ++i) {
        const int pi = wg * NA + i;
#pragma unroll
        for (int mc = 0; mc < 2; ++mc)
#pragma unroll
          for (int sc = 0; sc < 4; ++sc)
            if (pi == mc * 4 + sc) O[mc] = MFMA(cur.a[i], cur.v[sc], O[mc]);
      }
      u32* rp = reinterpret_cast<u32*>(red) + ((size_t)((cnt & 1) * 8 + wv) * 16) * 64 + lane;
#pragma unroll
      for (int mt = 0; mt < 2; ++mt)
#pragma unroll
        for (int r2 = 0; r2 < 8; ++r2) rp[(mt * 8 + r2) * 64] = pack2(O[mt][2 * r2], O[mt][2 * r2 + 1]);
#pragma unroll
      for (int s16 = 0; s16 < 4; ++s16) S = MFMA(cur.k[s16], cur.v[s16], S);
#pragma unroll
      for (int g4 = 0; g4 < 4; ++g4) {
        S[4 * g4 + 0] *= cur.dl[g4].x; S[4 * g4 + 1] *= cur.dl[g4].y; S[4 * g4 + 2] *= cur.dl[g4].z; S[4 * g4 + 3] *= cur.dl[g4].w;
      }
      asm volatile("s_waitcnt lgkmcnt(0)" ::: "memory");
      __builtin_amdgcn_s_barrier();
      asm volatile("" ::: "memory");
      {
        const u32* rg = reinterpret_cast<const u32*>(red) + ((size_t)((cnt & 1) * 8 + grp * WPI) * 16) * 64 + lane;
#pragma unroll
        for (int i = 0; i < NV; i += 2) {
          float sum0 = 0.f, sum1 = 0.f;
#pragma unroll
          for (int w2 = 0; w2 < WPI; ++w2) { const u32 pk = rg[((size_t)w2 * 16 + (wg * NV + i) / 2) * 64]; sum0 += bflo(pk); sum1 += bfhi(pk); }
          osum[i >> 1] = pack2(sum0, sum1);
        }
        if (!DEFER) store_o(row0);
      }
      ++cnt;
      if (ch + 1 < nch) cur = nxt;
    }
    if (DEFER) store_o(seq < 4 ? (size_t)(cg0 + nch - 1) * 64 : (size_t)PROWS + (size_t)(seq - 4) * 32);
#pragma unroll
    for (int reg = 0; reg < 16; ++reg) st_out[sbase + (size_t)crow(reg, hh) * VH] = S[reg];
  }
}

DI void gate_phase(u16* hb, const u16* proj, int ld, int zoff, const float* w, int G, float scale) {
  const int tid = opq(threadIdx.x); const int lane = tid & 63, wv = tid >> 6;
  for (int row = blockIdx.x * 8 + wv; row < MROWS; row += gridDim.x * 8) {
    u32x2* hp = reinterpret_cast<u32x2*>(hb + (size_t)row * DM);
    const u32x2* zp = reinterpret_cast<const u32x2*>(proj + (size_t)row * ld + zoff);
    float o[8][4], ss[8];
#pragma unroll
    for (int i = 0; i < 8; ++i) {
      const u32x2 pk = hp[i * 64 + lane];
      o[i][0] = bflo(pk.x); o[i][1] = bfhi(pk.x); o[i][2] = bflo(pk.y); o[i][3] = bfhi(pk.y);
      ss[i] = o[i][0] * o[i][0] + o[i][1] * o[i][1] + o[i][2] * o[i][2] + o[i][3] * o[i][3];
    }
#pragma unroll
    for (int i = 0; i < 8; ++i) ss[i] = wave_sum(ss[i]);
    if (G == 512) {
#pragma unroll
      for (int i = 0; i < 8; i += 2) { const float t = ss[i] + ss[i + 1]; ss[i] = t; ss[i + 1] = t; }
    } else if (G == 2048) {
      float t = 0.f;
#pragma unroll
      for (int i = 0; i < 8; ++i) t += ss[i];
#pragma unroll
      for (int i = 0; i < 8; ++i) ss[i] = t;
    }
    const float invG = 1.f / (float)G;
#pragma unroll
    for (int i = 0; i < 8; ++i) {
      const float r = rsqrtf(ss[i] * invG + 1e-6f) * scale;
      const int col = i * 256 + lane * 4;
      const float4 ww = *reinterpret_cast<const float4*>(w + (col & (G - 1)));
      const u32x2 zk = __builtin_nontemporal_load(zp + i * 64 + lane);
      const float z0 = bflo(zk.x), z1 = bfhi(zk.x), z2 = bflo(zk.y), z3 = bfhi(zk.y);
      const float g0 = o[i][0] * r * ww.x * (z0 / (1.f + expf(-z0)));
      const float g1 = o[i][1] * r * ww.y * (z1 / (1.f + expf(-z1)));
      const float g2 = o[i][2] * r * ww.z * (z2 / (1.f + expf(-z2)));
      const float g3 = o[i][3] * r * ww.w * (z3 / (1.f + expf(-z3)));
      u32x2 ov = {pack2(g0, g1), pack2(g2, g3)};
      hp[i * 64 + lane] = ov;
    }
  }
}

constexpr size_t SZ_VTP = (size_t)4 * 8 * 256 * 4096;
constexpr size_t SZ_KS = (size_t)8 * 16 * 1088 * 128;
DI void diffprep_cache(const Params& p, char* prep, int rank, int nranks) {
  u16* VTP = reinterpret_cast<u16*>(prep);
  u16* KS = VTP + SZ_VTP;
  u16* VTS = KS + SZ_KS;
  const int tid0 = opq(threadIdx.x), half = tid0 >> 8, tid = tid0 & 255;
  for (int it = rank * 2 + half; it < 8 * 8 * 16; it += nranks * 2) {
    const int kt = it & 15, bh = it >> 4, b = bh >> 3, h = bh & 7;
    u16* dst = VTS + ((size_t)((b * 8 + h) * 256 + tid)) * 1088 + kt * 64;
    const float* src = p.cache_v + ((size_t)(b * 1024 + kt * 64) * 8 + h) * 256 + tid;
#pragma unroll
    for (int g16 = 0; g16 < 4; ++g16) {
      float v[16];
#pragma unroll
      for (int e = 0; e < 16; ++e) v[e] = __builtin_nontemporal_load(src + (size_t)(g16 * 16 + e) * 2048);
      u32x4 o0 = {pack2(v[0], v[1]), pack2(v[2], v[3]), pack2(v[8], v[9]), pack2(v[10], v[11])};
      u32x4 o1 = {pack2(v[4], v[5]), pack2(v[6], v[7]), pack2(v[12], v[13]), pack2(v[14], v[15])};
      *reinterpret_cast<u32x4*>(dst + g16 * 16) = o0;
      *reinterpret_cast<u32x4*>(dst + g16 * 16 + 8) = o1;
    }
  }
  const int nchunks = 8 * 16 * 1024 * 16;
  for (int id = rank * 512 + tid0; id < nchunks; id += nranks * 512) {
    const int d8 = id & 15, rest = id >> 4, key = rest & 1023, bn = rest >> 10, b = bn >> 4, n = bn & 15;
    const float4* sp = reinterpret_cast<const float4*>(p.cache_k + ((size_t)(b * 1024 + key) * 16 + n) * 128 + d8 * 8);
    const float4 a = sp[0], c = sp[1];
    u32x4 o = {pack2(a.x, a.y), pack2(a.z, a.w), pack2(c.x, c.y), pack2(c.z, c.w)};
    *reinterpret_cast<u32x4*>(KS + ((size_t)(b * 16 + n) * 1088 + key) * 128 + d8 * 8) = o;
  }
}
DI void diffprep_phase(const Params& p, const u16* proj, char* prep, char* smem) {
  u16* VTP = reinterpret_cast<u16*>(prep);
  u16* KS = VTP + SZ_VTP;
  u16* VTS = KS + SZ_KS;
  const int tid0 = opq(threadIdx.x), half = tid0 >> 8, tid = tid0 & 255;
  u16* tl = reinterpret_cast<u16*>(smem) + half * (64 * 264);
  for (int it = blockIdx.x * 2 + half; it < 2048; it += gridDim.x * 2) {
    const int h = it & 7, c = (it >> 3) & 63, b = it >> 9;
    const u16* src = proj + (size_t)(b * 4096 + c * 64) * 8192 + 4096 + h * 256;
    __syncthreads();
#pragma unroll
    for (int i = 0; i < 8; ++i) {
      const int id = tid + 256 * i, t = id >> 5, ch = id & 31;
      *reinterpret_cast<u32x4*>(tl + t * 264 + ch * 8) = *reinterpret_cast<const u32x4*>(src + (size_t)t * 8192 + ch * 8);
    }
    __syncthreads();
    u16* dst = VTP + ((size_t)((b * 8 + h) * 256 + tid)) * 4096 + c * 64;
#pragma unroll
    for (int g16 = 0; g16 < 4; ++g16) {
      u32 pk[8];
#pragma unroll
      for (int e = 0; e < 8; ++e) {
        const int t = g16 * 16 + 2 * e;
        pk[e] = (u32)tl[t * 264 + tid] | ((u32)tl[(t + 1) * 264 + tid] << 16);
      }
      u32x4 o0 = {pk[0], pk[1], pk[4], pk[5]}, o1 = {pk[2], pk[3], pk[6], pk[7]};
      *reinterpret_cast<u32x4*>(dst + g16 * 16) = o0;
      *reinterpret_cast<u32x4*>(dst + g16 * 16 + 8) = o1;
    }
  }
  for (int it = blockIdx.x * 2 + half; it < 8 * 8; it += gridDim.x * 2) {
    const int b = it >> 3, h = it & 7;
    u16* dst = VTS + ((size_t)((b * 8 + h) * 256 + tid)) * 1088 + 16 * 64;
#pragma unroll
    for (int g16 = 0; g16 < 4; ++g16) {
      u32 pk[8];
#pragma unroll
      for (int e = 0; e < 8; ++e) {
        const int k0 = g16 * 16 + 2 * e;
        const u32 lo = k0 < 32 ? (u32)proj[(size_t)(PROWS + b * 32 + k0) * 8192 + 4096 + h * 256 + tid] : 0u;
        const u32 hi = k0 + 1 < 32 ? (u32)proj[(size_t)(PROWS + b * 32 + k0 + 1) * 8192 + 4096 + h * 256 + tid] : 0u;
        pk[e] = lo | (hi << 16);
      }
      u32x4 o0 = {pk[0], pk[1], pk[4], pk[5]}, o1 = {pk[2], pk[3], pk[6], pk[7]};
      *reinterpret_cast<u32x4*>(dst + g16 * 16) = o0;
      *reinterpret_cast<u32x4*>(dst + g16 * 16 + 8) = o1;
    }
  }
  const int nchunks = 8 * 16 * 64 * 16;
  for (int id = blockIdx.x * 512 + tid0; id < nchunks; id += gridDim.x * 512) {
    const int d8 = id & 15, rest = id >> 4, kl = rest & 63, bn = rest >> 6, b = bn >> 4, n = bn & 15;
    u32x4 o = {0u, 0u, 0u, 0u};
    if (kl < 32) o = *reinterpret_cast<const u32x4*>(proj + (size_t)(PROWS + b * 32 + kl) * 8192 + 2048 + n * 128 + d8 * 8);
    *reinterpret_cast<u32x4*>(KS + ((size_t)(b * 16 + n) * 1088 + 1024 + kl) * 128 + d8 * 8) = o;
  }
}

DI void attn_phase(const Params& p, const u16* proj, const char* prep, u16* obuf, char* smem) {
  const u16* VTP = reinterpret_cast<const u16*>(prep);
  const u16* KS = VTP + SZ_VTP;
  const u16* VTS = KS + SZ_KS;
  constexpr int BUFE = 2 * 64 * 136 + 256 * 72;
  u16* lds = reinterpret_cast<u16*>(smem);
  float* Ot = reinterpret_cast<float*>(smem);
  const int tid = opq(threadIdx.x), lane = tid & 63, wv = __builtin_amdgcn_readfirstlane(tid >> 6), l31 = lane & 31, hh = lane >> 5;
  const int qt = wv & 1, jh = (wv >> 1) & 1, vh = wv >> 2;
  const int G = gridDim.x;
  bool xcdmap = (G == 256);
  int xx = (int)blockIdx.x & 7, yy = (int)blockIdx.x >> 3;
  if (xcdmap) {
    const unsigned* bar = reinterpret_cast<const unsigned*>(p.ws + WS_BAR);
    bool even = true;
#pragma unroll
    for (int jx = 0; jx < 8; ++jx) even = even && (bar[256 + 64 * jx] == 32u);
    if (even) {
      const unsigned sl = reinterpret_cast<volatile unsigned*>(smem + LDS_BYTES - 16)[2];
      xx = (int)(sl >> 16) & 7; yy = (int)(sl & 31u);
    }
  }
  xx = __builtin_amdgcn_readfirstlane(xx); yy = __builtin_amdgcn_readfirstlane(yy);
  const int nrounds = xcdmap ? 9 : (2048 + 64 + G - 1) / G;
  for (int r = 0; r < nrounds; ++r) {
    int i;
    if (xcdmap) {
      const int x = xx, y = yy;
      if (r < 8) { const int bh = x * 4 + (r >> 1), c = (r & 1) ? y : 63 - y; i = ((63 - c) << 5) | bh; }
      else { i = (x * 32 + y) < 64 ? 2048 + (x * 32 + y) : 1 << 30; }
    } else {
      i = r * G + (int)blockIdx.x;
    }
    if (i >= 2048 + 64) continue;
    int b, h, nt, nkeys, nq; size_t qrow0, kstride, khs, vtstride; const u16* kbase; const u16* vtbase;
    if (i < 2048) {
      const int c = 63 - (i >> 5), bh = i & 31; b = bh >> 3; h = bh & 7; nt = c + 1; nkeys = nt * 64; nq = 64;
      qrow0 = (size_t)b * 4096 + c * 64;
      kbase = proj + (size_t)(b * 4096) * 8192 + 2048 + (2 * h) * 128; kstride = 8192; khs = 128;
      vtbase = VTP + (size_t)((b * 8 + h) * 256) * 4096; vtstride = 4096;
    } else {
      const int bh = i - 2048; b = bh >> 3; h = bh & 7; nt = 17; nkeys = 1056; nq = 32;
      qrow0 = (size_t)PROWS + b * 32;
      kbase = KS + (size_t)((b * 16 + 2 * h) * 1088) * 128; kstride = 128; khs = (size_t)1088 * 128;
      vtbase = VTS + (size_t)((b * 8 + h) * 256) * 1088; vtstride = 1088;
    }
    bf16x8 Qf[8];
    {
      const size_t qrow = qrow0 + ((qt * 32 < nq) ? qt * 32 : 0) + l31;
      const u16* qp = proj + qrow * 8192 + (2 * h + jh) * 128 + hh * 8;
#pragma unroll
      for (int s = 0; s < 8; ++s) Qf[s] = ld16(qp + s * 16);
#pragma unroll
      for (int s = 0; s < 8; ++s) asm volatile("" : "+v"(Qf[s]));
    }
    u32x4 kr[4], vr[4];
    auto gload = [&](int kt) {
#pragma unroll
      for (int ii = 0; ii < 4; ++ii) {
        const int id = tid + 512 * ii;
        const int jl = id >> 10, key = (id >> 4) & 63, ch = id & 15;
        kr[ii] = *reinterpret_cast<const u32x4*>(kbase + jl * khs + (size_t)(kt * 64 + key) * kstride + ch * 8);
        const int vd = id >> 3, cv = id & 7;
        vr[ii] = *reinterpret_cast<const u32x4*>(vtbase + (size_t)vd * vtstride + kt * 64 + cv * 8);
      }
    };
    auto sstore = [&](int buf) {
      u16* Ks = lds + buf * BUFE; u16* Vt = Ks + 2 * 64 * 136;
#pragma unroll
      for (int ii = 0; ii < 4; ++ii) {
        const int id = tid + 512 * ii;
        const int jl = id >> 10, key = (id >> 4) & 63, ch = id & 15;
        *reinterpret_cast<u32x4*>(Ks + (jl * 64 + key) * 136 + ch * 8) = kr[ii];
        const int vd = id >> 3, cv = id & 7;
        *reinterpret_cast<u32x4*>(Vt + vd * 72 + cv * 8) = vr[ii];
      }
    };
    float m = -1e30f, l = 0.f;
    f32x16 O[4];
#pragma unroll
    for (int vt = 0; vt < 4; ++vt) O[vt] = zero16();
#define ATT_BAR() do { asm volatile("s_waitcnt lgkmcnt(0)" ::: "memory"); __builtin_amdgcn_s_barrier(); asm volatile("" ::: "memory"); } while (0)
    const bool grpB = vh != 0;
    gload(0);
    __syncthreads();
    sstore(0);
    __syncthreads();
    if (nt > 1) gload(1);
    if (grpB) ATT_BAR();
    for (int kt = 0; kt < nt; ++kt) {
      const u16* Ks = lds + (kt & 1) * BUFE; const u16* Vt = Ks + 2 * 64 * 136;
      f32x16 st[2];
      __builtin_amdgcn_s_setprio(1);
#pragma unroll
      for (int kti = 0; kti < 2; ++kti) {
        st[kti] = zero16();
#pragma unroll
        for (int s = 0; s < 8; ++s) {
          const bf16x8 a = ld16(Ks + (jh * 64 + kti * 32 + l31) * 136 + s * 16 + hh * 8);
          st[kti] = MFMA(a, Qf[s], st[kti]);
        }
      }
      __builtin_amdgcn_s_setprio(0);
      constexpr float SC = 0.08838834764831845f * 1.4426950408889634f;
      if ((kt + 1) * 64 > nkeys) {
#pragma unroll
        for (int kti = 0; kti < 2; ++kti)
#pragma unroll
          for (int reg = 0; reg < 16; ++reg)
            if (kt * 64 + kti * 32 + crow(reg, hh) >= nkeys) st[kti][reg] = -1e30f;
      }
      float mx = -1e30f;
#pragma unroll
      for (int kti = 0; kti < 2; ++kti)
#pragma unroll
        for (int reg = 0; reg < 16; ++reg) mx = fmaxf(mx, st[kti][reg]);
      mx = fmaxf(mx, __shfl_xor(mx, 32)) * SC;
      const bool bump = __any(mx > m + 8.f);
      const float mn = bump ? fmaxf(m, mx) : m;
      float rs = 0.f;
#pragma unroll
      for (int kti = 0; kti < 2; ++kti)
#pragma unroll
        for (int reg = 0; reg < 16; ++reg) {
          const float pv = __builtin_amdgcn_exp2f(st[kti][reg] * SC - mn);
          st[kti][reg] = pv; rs += pv;
        }
      rs += __shfl_xor(rs, 32);
      if (bump) {
        const float alpha = __builtin_amdgcn_exp2f(m - mn);
        l *= alpha;
#pragma unroll
        for (int vt = 0; vt < 4; ++vt)
#pragma unroll
          for (int reg = 0; reg < 16; ++reg) O[vt][reg] *= alpha;
      }
      l += rs; m = mn;
      if (grpB && kt + 1 < nt) { sstore((kt + 1) & 1); if (kt + 2 < nt) gload(kt + 2); }
      ATT_BAR();
      __builtin_amdgcn_s_setprio(1);
#pragma unroll
      for (int kti = 0; kti < 2; ++kti) {
        {
          const bf16x8 pf = packacc<0>(st[kti]);
#pragma unroll
          for (int vt = 0; vt < 4; ++vt) {
            O[vt] = MFMA(ld16(Vt + ((vh * 4 + vt) * 32 + l31) * 72 + kti * 32 + 8 * hh), pf, O[vt]);
          }
        }
        {
          const bf16x8 pf = packacc<1>(st[kti]);
#pragma unroll
          for (int vt = 0; vt < 4; ++vt) {
            O[vt] = MFMA(ld16(Vt + ((vh * 4 + vt) * 32 + l31) * 72 + kti * 32 + 16 + 8 * hh), pf, O[vt]);
          }
        }
      }
      __builtin_amdgcn_s_setprio(0);
      if (!grpB && kt + 1 < nt) { sstore((kt + 1) & 1); if (kt + 2 < nt) gload(kt + 2); }
      ATT_BAR();
    }
    if (!grpB) ATT_BAR();
#undef ATT_BAR
    const float inv = 1.f / l;
    float lam;
    {
      const float* lp = p.diff_lambda;
      float s1 = lp[lane] * lp[128 + lane] + lp[64 + lane] * lp[192 + lane];
      float s2 = lp[256 + lane] * lp[384 + lane] + lp[320 + lane] * lp[448 + lane];
      s1 = wave_sum(s1); s2 = wave_sum(s2);
      lam = expf(s1) - expf(s2) + LAM_INIT;
    }
    if (jh == 1) {
#pragma unroll
      for (int vt = 0; vt < 4; ++vt)
#pragma unroll
        for (int reg = 0; reg < 16; ++reg) Ot[(qt * 32 + l31) * 257 + (vh * 4 + vt) * 32 + crow(reg, hh)] = lam * O[vt][reg] * inv;
    }
    __syncthreads();
    if (jh == 0) {
#pragma unroll
      for (int vt = 0; vt < 4; ++vt)
#pragma unroll
        for (int reg = 0; reg < 16; ++reg) {
          const int idx = (qt * 32 + l31) * 257 + (vh * 4 + vt) * 32 + crow(reg, hh);
          Ot[idx] = O[vt][reg] * inv - Ot[idx];
        }
    }
    __syncthreads();
    {
#pragma unroll 1
      for (int rr = 0; rr < 8; ++rr) {
        const int q = wv * 8 + rr;
        const float a0 = Ot[q * 257 + lane], a1 = Ot[q * 257 + 64 + lane], a2 = Ot[q * 257 + 128 + lane], a3 = Ot[q * 257 + 192 + lane];
        float ss = wave_sum(a0 * a0 + a1 * a1 + a2 * a2 + a3 * a3);
        if (lane == 0) Ot[q * 257 + 256] = rsqrtf(ss * (1.f / 256.f) + 1e-6f) * (1.f - LAM_INIT);
      }
    }
    __syncthreads();
    {
      u32 zk[16];
      const int te = opq(tid);
#pragma unroll
      for (int ii = 0; ii < 16; ++ii) {
        const int id = te + 512 * ii, q = id >> 7, vd = (id & 127) * 2;
        zk[ii] = *reinterpret_cast<const u32*>(proj + (qrow0 + (q < nq ? q : 0)) * 8192 + 6144 + h * 256 + vd);
      }
      const int vd0 = (te & 127) * 2;
      const float w0 = p.diff_subln_w[vd0], w1 = p.diff_subln_w[vd0 + 1];
#pragma unroll
      for (int ii = 0; ii < 16; ++ii) {
        const int id = te + 512 * ii, q = id >> 7, vd = (id & 127) * 2;
        if (q < nq) {
          const float r = Ot[q * 257 + 256];
          const float z0 = bflo(zk[ii]), z1 = bfhi(zk[ii]);
          const float g0 = Ot[q * 257 + vd] * r * w0 * (z0 / (1.f + __builtin_amdgcn_exp2f(-z0 * 1.4426950408889634f)));
          const float g1 = Ot[q * 257 + vd + 1] * r * w1 * (z1 / (1.f + __builtin_amdgcn_exp2f(-z1 * 1.4426950408889634f)));
          *reinterpret_cast<u32*>(obuf + (qrow0 + q) * DM + h * 256 + vd) = pack2(g0, g1);
        }
      }
    }
  }
}

#define XB_TMO      128
#define XB_XCNT(j)  (256  + 64 * (j))
#define XB_XSUB(j)  (1280 + 64 * (j))
#define XB_XGEN(j)  (2304 + 64 * (j))
#define XB_TOP      3328
#define XB_TOPGEN   3392
#define XCD_BAR_WORDS 3456
#define XB_SPIN_CAP (1u << 18)
DI unsigned xb_ld(unsigned* p) { return __hip_atomic_load(p, __ATOMIC_RELAXED, __HIP_MEMORY_SCOPE_AGENT); }
DI unsigned xb_add(unsigned* p, unsigned v) { return __hip_atomic_fetch_add(p, v, __ATOMIC_RELAXED, __HIP_MEMORY_SCOPE_AGENT); }
DI unsigned xb_xcc_id() { return (unsigned)__builtin_amdgcn_s_getreg((3 << 11) | 20) & 0xFu; }
#define XB_SPIN(cond, bar) do { unsigned _sp = 0; while (cond) { __builtin_amdgcn_s_sleep(1); \
    if ((++_sp & 255u) == 0u) { if (xb_ld(&(bar)[XB_TMO])) break; if (_sp > XB_SPIN_CAP) { atomicAdd(&(bar)[XB_TMO], 1u); break; } } } } while (0)
struct XcdBarrier { unsigned* bar; unsigned x; volatile LAS unsigned* st; };
DI XcdBarrier xcd_barrier_post(unsigned* bar, volatile LAS unsigned* st) {
  XcdBarrier b; b.bar = bar; b.x = xb_xcc_id(); b.st = st;
  if (threadIdx.x == 0) (void)xb_add(&bar[XB_XCNT(b.x)], 1u);
  return b;
}
DI void xcd_barrier_complete(unsigned* bar, unsigned x, unsigned& nloc, unsigned& nx) {
  const unsigned G = gridDim.x * gridDim.y * gridDim.z;
  unsigned sum, cnt, mine, sp = 0u;
  for (;;) {
    sum = 0u; cnt = 0u; mine = 0u;
#pragma unroll
    for (unsigned j = 0; j < 16; ++j) { const unsigned c = xb_ld(&bar[XB_XCNT(j)]); sum += c; cnt += (c > 0u) ? 1u : 0u; mine = (j == x) ? c : mine; }
    if (sum == G) break;
    __builtin_amdgcn_s_sleep(1);
    if ((++sp & 255u) == 0u) { if (xb_ld(&bar[XB_TMO])) break; if (sp > XB_SPIN_CAP) { atomicAdd(&bar[XB_TMO], 1u); break; } }
  }
  nloc = mine > 0u ? mine : 1u; nx = cnt > 0u ? cnt : 1u;
}
DI void xcd_barrier(const XcdBarrier& b) {
  asm volatile("s_waitcnt vmcnt(0)" ::: "memory");
  __syncthreads();
  if (threadIdx.x == 0) {
    unsigned* bar = b.bar;
    __builtin_amdgcn_s_waitcnt(0);
    unsigned nloc = b.st[0], nx = b.st[1];
    if (nloc == 0u) { xcd_barrier_complete(bar, b.x, nloc, nx); b.st[0] = nloc; b.st[1] = nx; }
    const unsigned old = xb_add(&bar[XB_XSUB(b.x)], 1u);
    const unsigned gen = old / nloc;
    if (old + 1u == (gen + 1u) * nloc) {
      __builtin_amdgcn_fence(__ATOMIC_RELEASE, "agent");
      asm volatile("s_waitcnt vmcnt(0)" ::: "memory");
      const unsigned og = xb_add(&bar[XB_TOP], 1u);
      const unsigned tg = og / nx;
      if (og + 1u == (tg + 1u) * nx) xb_add(&bar[XB_TOPGEN], 1u);
      else XB_SPIN(xb_ld(&bar[XB_TOPGEN]) == tg, bar);
      __builtin_amdgcn_fence(__ATOMIC_ACQUIRE, "agent");
      xb_add(&bar[XB_XGEN(b.x)], 1u);
      asm volatile("s_waitcnt vmcnt(0)" ::: "memory");
    } else {
      XB_SPIN(xb_ld(&bar[XB_XGEN(b.x)]) == gen, bar);
      __builtin_amdgcn_fence(__ATOMIC_ACQUIRE, "agent");
      asm volatile("s_waitcnt vmcnt(0)" ::: "memory");
    }
  }
  __syncthreads();
}

typedef const __attribute__((address_space(4))) Params* KPtr;
#if defined(__HIP_DEVICE_COMPILE__)
DI Params KP() { KPtr q = (KPtr)__builtin_amdgcn_kernarg_segment_ptr(); asm volatile("" : "+s"(q)); return *q; }
#else
DI Params KP() { return Params{}; }
#endif

DI void gsync(const Params& p, char* smem) {
  unsigned long long ba = reinterpret_cast<unsigned long long>(p.ws + WS_BAR);
  asm volatile("" : "+s"(ba));
  XcdBarrier b; b.bar = reinterpret_cast<unsigned*>(ba); b.x = xb_xcc_id();
  b.st = reinterpret_cast<volatile LAS unsigned*>((LAS unsigned char*)smem + LDS_BYTES - 16);
  xcd_barrier(b);
}

template <int LAYER>
DI void conv_layer(const Params& p, u16* WIN, u16* wout, int rank, int nranks) {
  constexpr int kind = LAYER % 3, j = LAYER / 3;
  if (kind == 0) {
    conv_job(p.gla_w_in + (size_t)j * 2048 * 6144, 6144, 6144, WIN, 0, rank, nranks);
    conv_job(p.gla_w_a1 + (size_t)j * 2048 * 16, 16, 16, WIN, 6144, rank, nranks);
    for (int id = rank * 512 + opq(threadIdx.x); id < 240 * 256; id += nranks * 512) {
      u32x4 z = {0u, 0u, 0u, 0u};
      reinterpret_cast<u32x4*>(WIN + (size_t)6160 * 2048)[id] = z;
    }
    conv_job(p.gla_w_out + (size_t)j * 2048 * 2048, 2048, 2048, wout, 0, rank, nranks);
  } else if (kind == 1) {
    conv_job(p.hgrn_w_in, 8192, 8192, WIN, 0, rank, nranks);
    conv_job(p.hgrn_w_out, 2048, 2048, wout, 0, rank, nranks);
  } else {
    conv_job(p.diff_w_in, 8192, 8192, WIN, 0, rank, nranks);
    conv_job(p.diff_w_out, 2048, 2048, wout, 0, rank, nranks);
  }
}

template <int LAYER>
DI void do_layer(char* smem, cg::grid_group& grid) {
  const Params p = KP();
  constexpr int layer = LAYER, kind = LAYER % 3, j = LAYER / 3;
  u16* WIN = reinterpret_cast<u16*>(p.ws + WS_WIN);
  u16* WOUT = reinterpret_cast<u16*>(p.ws + ((layer & 1) ? WS_WOUT1 : WS_WOUT));
  u16* WOUT_NEXT = reinterpret_cast<u16*>(p.ws + ((layer & 1) ? WS_WOUT : WS_WOUT1));
  u16* HB = reinterpret_cast<u16*>(p.ws + WS_H);
  u16* PROJ = reinterpret_cast<u16*>(p.ws + WS_PROJ);
  char* PREP_WS = p.ws + WS_PREP;
  char* PREP_OUT = reinterpret_cast<char*>(p.out + OFF_KP);
  if (layer == 0) conv_layer<0>(KP(), WIN, WOUT, blockIdx.x, gridDim.x);
  float* RS = reinterpret_cast<float*>(p.ws + WS_RS);
  u16* XW = reinterpret_cast<u16*>(p.ws + WS_XW);
  if (layer == 0) {
    norm_phase(p.x_prompt, p.x_sample, p.norm_w, HB);
    for (int i = blockIdx.x * 512 + opq(threadIdx.x); i < 4 * MROWS; i += gridDim.x * 512) RS[i] = 0.f;
    grid.sync();
    (void)xcd_barrier_post(reinterpret_cast<unsigned*>(p.ws + WS_BAR), reinterpret_cast<volatile LAS unsigned*>((LAS unsigned char*)smem + LDS_BYTES - 16));
    if (threadIdx.x == 0) {
      const unsigned x = xb_xcc_id();
      const unsigned y = xb_add(reinterpret_cast<unsigned*>(p.ws + WS_BAR) + 8 * x, 1u);
      reinterpret_cast<volatile unsigned*>(smem + LDS_BYTES - 16)[2] = (x << 16) | (y & 0xffffu);
    }
  }
  {
    pg8::EpiProj E; E.O = PROJ; E.ldc = kind == 0 ? GLA_LD : 8192; E.out = p.out; E.mode = kind == 2 ? 1 : 0;
    E.rs = layer == 0 ? nullptr : RS + (layer - 1) * MROWS;
    gemm8(smem, layer == 0 ? HB : XW, WIN, kind == 0 ? GLA_LD : 8192, E);
  }
  gsync(KP(), smem);
  if (kind == 0) {
    prep_phase<0>(KP(), layer, j, PROJ, PREP_WS, smem);
    gsync(KP(), smem);
    seq_phase<0>(KP(), j, PREP_WS, HB, smem);
  } else if (kind == 1) {
    prep_phase<1>(KP(), layer, j, PROJ, PREP_OUT, smem);
    gsync(KP(), smem);
    seq_phase<1>(KP(), j, PREP_OUT, HB, smem);
    if ((int)blockIdx.x >= 128 && gridDim.x > 128) diffprep_cache(KP(), PREP_WS, (int)blockIdx.x - 128, (int)gridDim.x - 128);
    else if (gridDim.x <= 128) diffprep_cache(KP(), PREP_WS, blockIdx.x, gridDim.x);
  } else {
    diffprep_phase(KP(), PROJ, PREP_WS, smem);
    gsync(KP(), smem);
    attn_phase(KP(), PROJ, PREP_WS, HB, smem);
  }
  gsync(KP(), smem);
  if (kind == 0) gate_phase(HB, PROJ, GLA_LD, 4096, p.gla_norm_w + j * 512, 512, 1.f);
  else if (kind == 1) gate_phase(HB, PROJ, 8192, 6144, p.hgrn_norm_w, 2048, 1.f);
  if (kind != 2) gsync(KP(), smem);
  {
    pg8::EpiRes E; E.xp = p.x_prompt; E.xs = p.x_sample; E.out = p.out; E.layer = layer;
    E.wn = p.norm_w + (layer < 3 ? (layer + 1) * DM : 0); E.xw = layer < 3 ? XW : nullptr; E.rs = RS + layer * MROWS;
    gemm8(smem, HB, WOUT, 2048, E);
    if (layer < 3) {
      const int nwg = (MROWS / 256) * (2048 / 256), G = gridDim.x, R = nwg % G;
      if ((int)blockIdx.x >= R) conv_layer<(LAYER + 1) % 4>(KP(), WIN, WOUT_NEXT, (int)blockIdx.x - R, G - R);
    }
  }
  gsync(KP(), smem);
}

__global__ void __launch_bounds__(512) mega(Params p) {
  extern __shared__ __attribute__((aligned(16))) char smem[];
  cg::grid_group grid = cg::this_grid();
  {
    unsigned* bar = reinterpret_cast<unsigned*>(p.ws + WS_BAR);
    if (blockIdx.x == 0) for (int i = threadIdx.x; i < XCD_BAR_WORDS; i += 512) bar[i] = 0u;
    if (threadIdx.x < 4) reinterpret_cast<volatile unsigned*>(smem + LDS_BYTES - 16)[threadIdx.x] = 0u;
    __syncthreads();
  }
  do_layer<0>(smem, grid);
  do_layer<1>(smem, grid);
  do_layer<2>(smem, grid);
  do_layer<3>(smem, grid);
  final_norm_phase(p.out, p.final_norm_w, reinterpret_cast<const float*>(p.ws + WS_RS) + 3 * MROWS);
}

extern "C" void kernel_launch(void* const* d_in, const int* in_sizes, int n_in, void* d_out, int out_size, void* d_ws, size_t ws_size,
                              hipStream_t stream) {
  Params p{};
  p.x_prompt = (const float*)d_in[0]; p.x_sample = (const float*)d_in[1]; p.state_gla = (const float*)d_in[2]; p.state_hgrn = (const float*)d_in[3];
  p.cache_k = (const float*)d_in[4]; p.cache_v = (const float*)d_in[5]; p.norm_w = (const float*)d_in[6]; p.final_norm_w = (const float*)d_in[7];
  p.gla_w_in = (const float*)d_in[8]; p.gla_w_a1 = (const float*)d_in[9]; p.gla_w_a2 = (const float*)d_in[10]; p.gla_b_a = (const float*)d_in[11];
  p.gla_norm_w = (const float*)d_in[12]; p.gla_w_out = (const float*)d_in[13];
  p.hgrn_w_in = (const float*)d_in[14]; p.hgrn_lb = (const float*)d_in[15]; p.hgrn_norm_w = (const float*)d_in[16]; p.hgrn_w_out = (const float*)d_in[17];
  p.diff_w_in = (const float*)d_in[18]; p.diff_lambda = (const float*)d_in[19]; p.diff_subln_w = (const float*)d_in[20]; p.diff_w_out = (const float*)d_in[21];
  p.out = (float*)d_out; p.ws = (char*)d_ws;
  static int grid_blocks = 0;
  if (!grid_blocks) {
    int dev = 0, cus = 0, per_cu = 0;
    (void)hipGetDevice(&dev);
    (void)hipFuncSetAttribute((const void*)mega, hipFuncAttributeMaxDynamicSharedMemorySize, (int)LDS_BYTES);
    (void)hipDeviceGetAttribute(&cus, hipDeviceAttributeMultiprocessorCount, dev);
    (void)hipOccupancyMaxActiveBlocksPerMultiprocessor(&per_cu, mega, 512, LDS_BYTES);
    if (per_cu < 1) per_cu = 1;
    if (per_cu > 1) per_cu = 1;
    grid_blocks = cus * per_cu;
  }
  void* args[] = {&p};
  hipError_t e = hipLaunchCooperativeKernel((void*)mega, dim3(grid_blocks), dim3(512), args, LDS_BYTES, stream);
  if (e != hipSuccess) fprintf(stderr, "cooperative launch failed: %s (grid %d)\n", hipGetErrorString(e), grid_blocks);
}
```

```cpp
#include <hip/hip_runtime.h>
#include <hip/hip_cooperative_groups.h>
#include <cstdio>
namespace cg = cooperative_groups;

typedef unsigned short u16;
typedef unsigned int u32;
using bf16x8 = __attribute__((ext_vector_type(8))) short;
using f32x16 = __attribute__((ext_vector_type(16))) float;
using f32x4 = __attribute__((ext_vector_type(4))) float;
using u32x4 = __attribute__((ext_vector_type(4))) unsigned;
using u32x2 = __attribute__((ext_vector_type(2))) unsigned;

#define DI __device__ __forceinline__
#define MFMA(a, b, c) __builtin_amdgcn_mfma_f32_32x32x16_bf16((a), (b), (c), 0, 0, 0)
#define LAS __attribute__((address_space(3)))

constexpr int MROWS = 16640;
constexpr int PROWS = 16384;
constexpr int DM = 2048;
constexpr size_t OFF_GSP = 34078720;
constexpr size_t OFF_GSS = 38273024;
constexpr size_t OFF_HSP = 46661632;
constexpr size_t OFF_HSS = 47710208;
constexpr size_t OFF_KP = 49807360;
constexpr size_t OFF_VP = 83361792;
constexpr size_t OFF_KS = 116916224;
constexpr size_t OFF_VS = 117440512;
constexpr size_t WS_WIN = 0;
constexpr size_t WS_WOUT = 33554432;
constexpr size_t WS_H = 41943040;
constexpr size_t WS_PROJ = 110100480;
constexpr size_t WS_PREP = 382730240;
constexpr size_t WS_XW = 530874368;
constexpr size_t WS_BAR = 599031808;
constexpr size_t WS_RS = 599048192;
constexpr size_t WS_WOUT1 = 599314432;
constexpr size_t LDS_BYTES = 147456;
constexpr float LAM_INIT = 0.47071302f;
constexpr int GLA_LD = 6400;

struct Params {
  const float* x_prompt; const float* x_sample; const float* state_gla; const float* state_hgrn;
  const float* cache_k; const float* cache_v; const float* norm_w; const float* final_norm_w;
  const float* gla_w_in; const float* gla_w_a1; const float* gla_w_a2; const float* gla_b_a;
  const float* gla_norm_w; const float* gla_w_out;
  const float* hgrn_w_in; const float* hgrn_lb; const float* hgrn_norm_w; const float* hgrn_w_out;
  const float* diff_w_in; const float* diff_lambda; const float* diff_subln_w; const float* diff_w_out;
  float* out; char* ws;
};

typedef __bf16 bf16v2 __attribute__((ext_vector_type(2)));
typedef float f32v2 __attribute__((ext_vector_type(2)));
DI u32 pack2(float a, float b) { f32v2 v = {a, b}; return __builtin_bit_cast(u32, __builtin_convertvector(v, bf16v2)); }
DI u16 f2bf(float x) { return (u16)(pack2(x, 0.f) & 0xffffu); }
DI float bf2f(u16 b) { return __uint_as_float(((u32)b) << 16); }
DI float bflo(u32 p) { return __uint_as_float(p << 16); }
DI float bfhi(u32 p) { return __uint_as_float(p & 0xffff0000u); }
DI bf16x8 ld16(const u16* p) { return *reinterpret_cast<const bf16x8*>(p); }
DI bf16x8 ld8x2(const u16* p0, const u16* p1) {
  u32x2 a = *reinterpret_cast<const u32x2*>(p0); u32x2 b = *reinterpret_cast<const u32x2*>(p1);
  u32x4 r = {a.x, a.y, b.x, b.y}; return __builtin_bit_cast(bf16x8, r);
}
DI int opq(int x) { asm volatile("" : "+v"(x)); return x; }
DI int crow(int reg, int hh) { return (reg & 3) + 8 * (reg >> 2) + 4 * hh; }
template <int S> DI bf16x8 packacc(const f32x16& x) {
  u32x4 r = {pack2(x[8 * S], x[8 * S + 1]), pack2(x[8 * S + 2], x[8 * S + 3]), pack2(x[8 * S + 4], x[8 * S + 5]), pack2(x[8 * S + 6], x[8 * S + 7])};
  return __builtin_bit_cast(bf16x8, r);
}
DI float wave_sum(float v) {
#pragma unroll
  for (int o = 32; o > 0; o >>= 1) v += __shfl_xor(v, o);
  return v;
}
DI f32x16 zero16() { f32x16 z;
#pragma unroll
  for (int i = 0; i < 16; ++i) z[i] = 0.f;
  return z; }

DI void conv_job(const float* W, int ldw, int ncols, u16* Wt, int drow0, int rank, int nranks) {
  const int tid = opq(threadIdx.x), lane = tid & 63, wv = tid >> 6;
  const int ntn = (ncols + 63) >> 6;
  const int ntiles = 64 * ntn;
  for (int tile = rank * 8 + wv; tile < ntiles; tile += nranks * 8) {
    const int tn = tile % ntn, tk = tile / ntn;
    const int n = tn * 64 + lane, k0 = tk * 32;
    if (n < ncols) {
      const float* src = W + (size_t)k0 * ldw + n;
      float v[32];
#pragma unroll
      for (int i = 0; i < 32; ++i) v[i] = __builtin_nontemporal_load(src + (size_t)i * ldw);
      u32x4* dst = reinterpret_cast<u32x4*>(Wt + (size_t)(drow0 + n) * 2048 + k0);
#pragma unroll
      for (int i = 0; i < 4; ++i) {
        u32x4 o = {pack2(v[8 * i], v[8 * i + 1]), pack2(v[8 * i + 2], v[8 * i + 3]), pack2(v[8 * i + 4], v[8 * i + 5]), pack2(v[8 * i + 6], v[8 * i + 7])};
        dst[i] = o;
      }
    }
  }
}

DI void norm_phase(const float* xp, const float* xs, const float* w, u16* h) {
  const int tid = opq(threadIdx.x); const int lane = tid & 63, wv = tid >> 6;
  for (int row = blockIdx.x * 8 + wv; row < MROWS; row += gridDim.x * 8) {
    const float* src = row < PROWS ? xp + (size_t)row * DM : xs + (size_t)(row - PROWS) * DM;
    float4 v[8]; float ss = 0.f;
#pragma unroll
    for (int i = 0; i < 8; ++i) { const f32x4 t4 = __builtin_nontemporal_load(reinterpret_cast<const f32x4*>(src) + i * 64 + lane); v[i] = make_float4(t4[0], t4[1], t4[2], t4[3]); ss += v[i].x * v[i].x + v[i].y * v[i].y + v[i].z * v[i].z + v[i].w * v[i].w; }
    ss = wave_sum(ss);
    const float r = rsqrtf(ss * (1.f / 2048.f) + 1e-6f);
    u32x2* dst = reinterpret_cast<u32x2*>(h + (size_t)row * DM);
#pragma unroll
    for (int i = 0; i < 8; ++i) {
      const float4 ww = reinterpret_cast<const float4*>(w)[i * 64 + lane];
      u32x2 o = {pack2(v[i].x * r * ww.x, v[i].y * r * ww.y), pack2(v[i].z * r * ww.z, v[i].w * r * ww.w)};
      dst[i * 64 + lane] = o;
    }
  }
}

DI void final_norm_phase(float* y, const float* w, const float* rs) {
  const int tid = opq(threadIdx.x); const int lane = tid & 63, wv = tid >> 6;
  for (int row = blockIdx.x * 8 + wv; row < MROWS; row += gridDim.x * 8) {
    float4* src = reinterpret_cast<float4*>(y + (size_t)row * DM);
    const float r = rsqrtf(rs[row] * (1.f / 2048.f) + 1e-6f);
#pragma unroll
    for (int i = 0; i < 8; ++i) {
      const float4 v = src[i * 64 + lane];
      const float4 ww = reinterpret_cast<const float4*>(w)[i * 64 + lane];
      f32x4 o = {v.x * r * ww.x, v.y * r * ww.y, v.z * r * ww.z, v.w * r * ww.w};
      __builtin_nontemporal_store(o, reinterpret_cast<f32x4*>(src) + i * 64 + lane);
    }
  }
}

namespace pg8 {
constexpr int BM = 256, BK = 64, HALF = 128, HTB = HALF * BK * 2, NXCD = 8, WGM = 8;
DI int lds_byte(int r, int c) { const int st = (r >> 4) * 2 + (c >> 5), rr = r & 15, cc = c & 31, ob = rr * 64 + cc * 2; return st * 1024 + (ob ^ (((ob >> 9) & 1) << 5)); }
DI void stage_rc(int b, int& R, int& C) { const int st = b / 1024, sb = b % 1024, swz = sb ^ (((sb >> 9) & 1) << 5); R = (st >> 1) * 16 + swz / 64; C = (st & 1) * 32 + (swz % 64) / 2; }
DI int perm32(int rho) { const int n = rho >> 4, i = rho & 15; return 8 * (i >> 2) + 4 * n + (i & 3); }
struct Unit { int pm, pn; };
struct Gemm { const u16* A; const u16* Bt; int M, N, K; };
struct StaticOrder {
  int nM, nN, nwg, G, c;
  DI void init(int M, int N, int G_, int c_) { nM = M / BM; nN = N / BM; nwg = nM * nN; G = G_; c = c_; }
  DI bool next(int i, Unit& u) const {
    const long L = (long)i * G + c; if (L >= nwg) return false;
    int wgid = (int)L; { const int q = nwg / NXCD, r = nwg % NXCD, xcd = wgid % NXCD, off = wgid / NXCD; wgid = (xcd < r ? xcd * (q + 1) : r * (q + 1) + (xcd - r) * q) + off; }
    const int nig = WGM * nN, gid = wgid / nig, fm = gid * WGM, gsz = (nM - fm) < WGM ? (nM - fm) : WGM;
    u.pm = fm + ((wgid % nig) % gsz); u.pn = (wgid % nig) / gsz; return true;
  }
};

template <class Epi>
DI void gemm_phase(LAS unsigned char* lds, const Gemm g, const StaticOrder& S, const Epi& E) {
  const int tid = opq(threadIdx.x), wid = __builtin_amdgcn_readfirstlane(tid >> 6), lane = tid & 63, wr = wid >> 2, wc = wid & 3, fr = lane & 15, fq = lane >> 4;
  const int K = g.K, nt = K / BK;
  unsigned voffA[2], voffB[2];
#pragma unroll
  for (int i = 0; i < 2; ++i) { int R, C; stage_rc(tid * 16 + i * 8192, R, C); const int Rb = Epi::PERM ? ((R & ~31) + perm32(R & 31)) : R;
    voffA[i] = (unsigned)(R * K + C) * 2u; voffB[i] = (unsigned)(Rb * K + C) * 2u; }
  const size_t kstep = (size_t)(BK * 2);
  const size_t hstep = (size_t)HALF * K * 2;
  const size_t tstep = 2 * hstep;
  const unsigned ldsw = (unsigned)wid * 1024u;
  const int aoff = lds_byte(wr * 64 + fr, fq * 8), boff = lds_byte(wc * 32 + fr, fq * 8);
#define PG8_SA(b, h) (((b) * 2 + (h)) * HTB)
#define PG8_SB(b, h) ((4 + (b) * 2 + (h)) * HTB)
#define PG8_STAGE(bufoff, gbase, voff) do { _Pragma("unroll") for (int _i = 0; _i < 2; ++_i) \
    __builtin_amdgcn_global_load_lds((const unsigned*)((const char*)(gbase) + (voff)[_i]), (LAS unsigned*)(lds + (bufoff) + ldsw + _i * 8192), 16, 0, 0); } while (0)
#define PG8_LDA(dst, b, h) do { _Pragma("unroll") for (int m = 0; m < 4; ++m) _Pragma("unroll") for (int k = 0; k < 2; ++k) dst[m][k] = *(const LAS bf16x8*)(lds + PG8_SA(b, h) + aoff + m * 2048 + k * 1024); } while (0)
#define PG8_LDB(dst, b, h) do { _Pragma("unroll") for (int n = 0; n < 2; ++n) _Pragma("unroll") for (int k = 0; k < 2; ++k) dst[n][k] = *(const LAS bf16x8*)(lds + PG8_SB(b, h) + boff + n * 2048 + k * 1024); } while (0)
#define PG8_MMA(ai, bj, At, Bt) do { __builtin_amdgcn_s_setprio(1); _Pragma("unroll") for (int m = 0; m < 4; ++m) _Pragma("unroll") for (int n = 0; n < 2; ++n) _Pragma("unroll") for (int k = 0; k < 2; ++k) \
    acc[ai][bj][m][n] = __builtin_amdgcn_mfma_f32_16x16x32_bf16(Bt[n][k], At[m][k], acc[ai][bj][m][n], 0, 0, 0); __builtin_amdgcn_s_setprio(0); } while (0)
#define PG8_WAIT_V(n) asm volatile("s_waitcnt vmcnt(" #n ")" ::: "memory")
#define PG8_WAIT_L(n) asm volatile("s_waitcnt lgkmcnt(" #n ")" ::: "memory")
#define PG8_BAR __builtin_amdgcn_s_barrier()
#define PG8_SCHED __builtin_amdgcn_sched_barrier(0)
  Unit cur, nxt; int ui = 0;
  if (!S.next(0, cur)) return;
  f32x4 acc[2][2][4][2];
#pragma unroll
  for (int a = 0; a < 2; ++a)
#pragma unroll
    for (int b = 0; b < 2; ++b)
#pragma unroll
      for (int m = 0; m < 4; ++m)
#pragma unroll
        for (int n = 0; n < 2; ++n) acc[a][b][m][n] = (f32x4){0.f, 0.f, 0.f, 0.f};
  bf16x8 At[4][2], B0[2][2], B1[2][2];
  const char* cA = (const char*)g.A + (size_t)cur.pm * tstep; const char* cB = (const char*)g.Bt + (size_t)cur.pn * tstep;
  PG8_STAGE(PG8_SB(0, 0), cB, voffB); PG8_STAGE(PG8_SA(0, 0), cA, voffA); PG8_STAGE(PG8_SB(0, 1), cB + hstep, voffB); PG8_STAGE(PG8_SA(0, 1), cA + hstep, voffA);
  if (wr == 1) PG8_BAR;
  PG8_WAIT_V(4); PG8_BAR;
  PG8_STAGE(PG8_SB(1, 0), cB + kstep, voffB); PG8_STAGE(PG8_SA(1, 0), cA + kstep, voffA); PG8_STAGE(PG8_SB(1, 1), cB + hstep + kstep, voffB);
  PG8_WAIT_V(6); PG8_BAR;
  for (;;) {
    const bool has_next = S.next(ui + 1, nxt);
    const char* nA = has_next ? (const char*)g.A + (size_t)nxt.pm * tstep : cA; const char* nB = has_next ? (const char*)g.Bt + (size_t)nxt.pn * tstep : cB;
    for (int t = 0; t < nt; t += 2) {
      const bool last = (t == nt - 2);
      const char* a1 = cA + (size_t)(t + 1) * kstep;
      const char* a2 = last ? nA : cA + (size_t)(t + 2) * kstep; const char* b2 = last ? nB : cB + (size_t)(t + 2) * kstep;
      const char* a3 = a2 + kstep; const char* b3 = b2 + kstep;
      PG8_LDB(B0, 0, 0); PG8_SCHED; PG8_LDA(At, 0, 0); PG8_STAGE(PG8_SA(1, 1), a1 + hstep, voffA);
      PG8_WAIT_L(8); PG8_BAR; PG8_WAIT_L(0); PG8_MMA(0, 0, At, B0); PG8_BAR; PG8_SCHED;
      PG8_LDB(B1, 0, 1); PG8_STAGE(PG8_SB(0, 0), b2, voffB);
      PG8_BAR; PG8_WAIT_L(0); PG8_MMA(0, 1, At, B1); PG8_BAR;
      PG8_LDA(At, 0, 1); PG8_STAGE(PG8_SA(0, 0), a2, voffA);
      PG8_BAR; PG8_WAIT_L(0); PG8_MMA(1, 0, At, B0); PG8_BAR; PG8_SCHED;
      PG8_STAGE(PG8_SB(0, 1), b2 + hstep, voffB);
      PG8_WAIT_V(6); PG8_BAR; PG8_MMA(1, 1, At, B1); PG8_BAR;
      PG8_LDB(B0, 1, 0); PG8_SCHED; PG8_LDA(At, 1, 0); PG8_STAGE(PG8_SA(0, 1), a2 + hstep, voffA);
      PG8_WAIT_L(8); PG8_BAR; PG8_WAIT_L(0); PG8_MMA(0, 0, At, B0); PG8_BAR; PG8_SCHED;
      PG8_LDB(B1, 1, 1); PG8_STAGE(PG8_SB(1, 0), b3, voffB);
      PG8_BAR; PG8_WAIT_L(0); PG8_MMA(0, 1, At, B1); PG8_BAR;
      PG8_LDA(At, 1, 1); PG8_STAGE(PG8_SA(1, 0), a3, voffA);
      PG8_BAR; PG8_WAIT_L(0); PG8_MMA(1, 0, At, B0); PG8_BAR; PG8_SCHED;
      PG8_STAGE(PG8_SB(1, 1), b3 + hstep, voffB);
      PG8_WAIT_V(6); PG8_BAR; PG8_MMA(1, 1, At, B1); PG8_BAR;
    }
    E(acc, cur, wr, wc, fr, fq);
    if (!has_next) break;
#pragma unroll
    for (int a = 0; a < 2; ++a)
#pragma unroll
      for (int b = 0; b < 2; ++b)
#pragma unroll
        for (int m = 0; m < 4; ++m)
#pragma unroll
          for (int n = 0; n < 2; ++n) acc[a][b][m][n] = (f32x4){0.f, 0.f, 0.f, 0.f};
    cur = nxt; cA = nA; cB = nB; ++ui;
  }
  PG8_WAIT_V(0);
  if (wr == 0) PG8_BAR;
  PG8_BAR;
#undef PG8_SA
#undef PG8_SB
#undef PG8_STAGE
#undef PG8_LDA
#undef PG8_LDB
#undef PG8_MMA
#undef PG8_WAIT_V
#undef PG8_WAIT_L
#undef PG8_BAR
#undef PG8_SCHED
}

struct EpiProj {
  static constexpr bool PERM = true;
  u16* O; int ldc; float* out; int mode; const float* rs;
  DI void operator()(const f32x4 (&acc)[2][2][4][2], const Unit& u, int wr, int wc, int fr, int fq) const {
    const int row0 = u.pm * BM + wr * 64 + fr, colt = u.pn * BM, col0 = colt + wc * 32 + 8 * fq;
    const bool kv = (mode == 1) && colt >= 2048 && colt < 6144;
    const int sec = colt >= 4096 ? 1 : 0;
#pragma unroll
    for (int ai = 0; ai < 2; ++ai)
#pragma unroll
      for (int m = 0; m < 4; ++m) {
        const int row = row0 + ai * HALF + m * 16;
        u16* rowp = O + (size_t)row * ldc + col0;
        const float rr = rs ? rsqrtf(rs[row] * (1.f / 2048.f) + 1e-6f) : 1.f;
#pragma unroll
        for (int bj = 0; bj < 2; ++bj) {
          const f32x4 v0 = acc[ai][bj][m][0] * rr, v1 = acc[ai][bj][m][1] * rr;
          u32x4 w = {pack2(v0[0], v0[1]), pack2(v0[2], v0[3]), pack2(v1[0], v1[1]), pack2(v1[2], v1[3])};
          *reinterpret_cast<u32x4*>(rowp + bj * HALF) = w;
          if (kv) {
            const int c2 = col0 + bj * HALF - 2048 - sec * 2048;
            float* dst = row < PROWS ? out + (sec ? OFF_VP : OFF_KP) + (size_t)row * DM + c2 : out + (sec ? OFF_VS : OFF_KS) + (size_t)(row - PROWS) * DM + c2;
            __builtin_nontemporal_store(v0, reinterpret_cast<f32x4*>(dst)); __builtin_nontemporal_store(v1, reinterpret_cast<f32x4*>(dst + 4));
          }
        }
      }
  }
};
struct EpiRes {
  static constexpr bool PERM = true;
  const float* xp; const float* xs; float* out; int layer; const float* wn; u16* xw; float* rs;
  DI void operator()(const f32x4 (&acc)[2][2][4][2], const Unit& u, int wr, int wc, int fr, int fq) const {
    const int row0 = u.pm * BM + wr * 64 + fr, col0 = u.pn * BM + wc * 32 + 8 * fq;
    f32x4 wv[2][2];
#pragma unroll
    for (int bj = 0; bj < 2; ++bj)
#pragma unroll
      for (int n = 0; n < 2; ++n) wv[bj][n] = xw ? *reinterpret_cast<const f32x4*>(wn + col0 + bj * HALF + n * 4) : (f32x4){0.f, 0.f, 0.f, 0.f};
#pragma unroll
    for (int ai = 0; ai < 2; ++ai)
#pragma unroll
      for (int m = 0; m < 4; ++m) {
        const int row = row0 + ai * HALF + m * 16;
        float* dst = out + (size_t)row * DM + col0;
        const float* src = layer == 0 ? (row < PROWS ? xp + (size_t)row * DM + col0 : xs + (size_t)(row - PROWS) * DM + col0) : dst;
        float ss = 0.f;
#pragma unroll
        for (int bj = 0; bj < 2; ++bj) {
          const f32x4 x0 = *reinterpret_cast<const f32x4*>(src + bj * HALF), x1 = *reinterpret_cast<const f32x4*>(src + bj * HALF + 4);
          const f32x4 n0 = x0 + acc[ai][bj][m][0], n1 = x1 + acc[ai][bj][m][1];
          *reinterpret_cast<f32x4*>(dst + bj * HALF) = n0; *reinterpret_cast<f32x4*>(dst + bj * HALF + 4) = n1;
          ss += n0[0] * n0[0] + n0[1] * n0[1] + n0[2] * n0[2] + n0[3] * n0[3] + n1[0] * n1[0] + n1[1] * n1[1] + n1[2] * n1[2] + n1[3] * n1[3];
          if (xw) {
            const f32x4 h0 = n0 * wv[bj][0], h1 = n1 * wv[bj][1];
            u32x4 pk = {pack2(h0[0], h0[1]), pack2(h0[2], h0[3]), pack2(h1[0], h1[1]), pack2(h1[2], h1[3])};
            *reinterpret_cast<u32x4*>(xw + (size_t)row * DM + col0 + bj * HALF) = pk;
          }
        }
        ss += __shfl_xor(ss, 16); ss += __shfl_xor(ss, 32);
        if (fq == 0) atomicAdd(rs + row, ss);
      }
  }
};
}

template <class Epi>
DI void gemm8(char* smem, const u16* A, const u16* Bt, int N, const Epi& E) {
  pg8::Gemm g; g.A = A; g.Bt = Bt; g.M = MROWS; g.N = N; g.K = 2048;
  pg8::StaticOrder S; S.init(MROWS, N, gridDim.x, blockIdx.x);
  pg8::gemm_phase<Epi>((LAS unsigned char*)smem, g, S, E);
}

template <int KIND> struct RC {
  static constexpr int H = KIND == 0 ? 4 : 16;
  static constexpr int KH = KIND == 0 ? 256 : 128;
  static constexpr int VH = KIND == 0 ? 512 : 128;
  static constexpr int HPB = 256 / KH;
  static constexpr int LD = KIND == 0 ? GLA_LD : 8192;
  static constexpr int NIT = 264 * H;
  static constexpr int VOFF = KIND == 0 ? 2048 : 4096;
  static constexpr size_t SZQ = (size_t)NIT * 64 * KH;
  static constexpr size_t SZV = (size_t)NIT * VH * 64;
};

template <int KIND>
DI void prep_phase(const Params& p, int layer, int j, const u16* proj, char* prep, char* smem) {
  using C = RC<KIND>;
  constexpr int H = C::H, KH = C::KH, VH = C::VH, HPB = C::HPB, LD = C::LD, KTH = KH / 32;
  constexpr float L2E = 1.4426950408889634f, LN2 = 0.6931471805599453f;
  u16* QF = reinterpret_cast<u16*>(prep);
  u16* KF = QF + C::SZQ;
  u16* VF = KF + C::SZQ;
  u16* AF = VF + C::SZV;
  float* DL = reinterpret_cast<float*>(AF + (size_t)C::NIT * 4096);
  const int tid = opq(threadIdx.x), half = tid >> 8, c = tid & 255, lane = tid & 63, wvl = (tid >> 6) & 3, l31 = lane & 31, hh = lane >> 5;
  u16* qs = reinterpret_cast<u16*>(smem) + half * (2 * 64 * 264 + 64 * 16);
  u16* ks = qs + 64 * 264;
  u16* as = ks + 64 * 264;
  constexpr int HG = H / HPB;
  const int nblk = 264 * HG;
  for (int bi = blockIdx.x * 2 + half; bi < nblk; bi += gridDim.x * 2) {
    const int cgk = bi / HG, hg = bi - cgk * HG;
    const int nvalid = cgk < 256 ? 64 : 32;
    const size_t row0 = cgk < 256 ? (size_t)cgk * 64 : (size_t)PROWS + (size_t)(cgk - 256) * 32;
    const int head = hg * HPB + c / KH, kk = c % KH;
    const int item = cgk * H + head;
    float w2[16]; float ba = 0.f, lb = 0.f;
    if (KIND == 0) {
#pragma unroll
      for (int r = 0; r < 16; ++r) w2[r] = p.gla_w_a2[(size_t)j * 16 * 1024 + r * 1024 + head * 256 + kk];
      ba = p.gla_b_a[j * 1024 + head * 256 + kk];
    } else {
#pragma unroll
      for (int r = 0; r < 16; ++r) w2[r] = 0.f;
      const int ch = head * 128 + kk;
      float l0 = p.hgrn_lb[ch], l1 = p.hgrn_lb[2048 + ch], l2 = p.hgrn_lb[4096 + ch], l3 = p.hgrn_lb[6144 + ch];
      float mx = fmaxf(fmaxf(l0, l1), fmaxf(l2, l3));
      float e0 = expf(l0 - mx), e1 = expf(l1 - mx), e2 = expf(l2 - mx), e3 = expf(l3 - mx);
      float inv = 1.f / (e0 + e1 + e2 + e3);
      float acc = 0.f;
      if (layer >= 1) acc += e1;
      if (layer >= 2) acc += e2;
      if (layer >= 3) acc += e3;
      lb = acc * inv;
    }
    __syncthreads();
    {
      const u16* qsrc = proj + row0 * LD + hg * 256;
      const u16* ksrc = qsrc + (KIND == 0 ? 1024 : 2048);
#pragma unroll
      for (int i = 0; i < 8; ++i) {
        const int id = c + 256 * i, t = id >> 5, ch = id & 31;
        u32x4 vq = {0u, 0u, 0u, 0u}, vk = {0u, 0u, 0u, 0u};
        if (t < nvalid) {
          vq = __builtin_nontemporal_load(reinterpret_cast<const u32x4*>(qsrc + (size_t)t * LD + ch * 8));
          vk = __builtin_nontemporal_load(reinterpret_cast<const u32x4*>(ksrc + (size_t)t * LD + ch * 8));
        }
        *reinterpret_cast<u32x4*>(qs + t * 264 + ch * 8) = vq;
        *reinterpret_cast<u32x4*>(ks + t * 264 + ch * 8) = vk;
      }
      if (KIND == 0 && c < 128) {
        const int t = c >> 1, part = c & 1;
        u32x4 va = {0u, 0u, 0u, 0u};
        if (t < nvalid) va = *reinterpret_cast<const u32x4*>(proj + (row0 + t) * LD + 6144 + part * 8);
        *reinterpret_cast<u32x4*>(as + t * 16 + part * 8) = va;
      }
    }
    __syncthreads();
    float b = 0.f;
    {
      const int kt = kk >> 5, kl = kk & 31;
      u16* kfb = KF + (size_t)item * 64 * KH + ((size_t)(kt * 4) * 64 + kl) * 8;
#pragma unroll 2
      for (int t8 = 0; t8 < 8; ++t8) {
        u32 pk[4];
#pragma unroll
        for (int e = 0; e < 4; ++e) {
          u16 kb[2];
#pragma unroll
          for (int q = 0; q < 2; ++q) {
            const int t = t8 * 8 + 2 * e + q;
            const float qr = bf2f(qs[t * 264 + c]), kr = bf2f(ks[t * 264 + c]);
            float qv, kv, g;
            if (KIND == 0) {
              qv = qr * 0.0625f; kv = kr;
              const u32x4 a0 = *reinterpret_cast<const u32x4*>(as + t * 16);
              const u32x4 a1 = *reinterpret_cast<const u32x4*>(as + t * 16 + 8);
              float x = ba;
              x += bflo(a0.x) * w2[0] + bfhi(a0.x) * w2[1] + bflo(a0.y) * w2[2] + bfhi(a0.y) * w2[3];
              x += bflo(a0.z) * w2[4] + bfhi(a0.z) * w2[5] + bflo(a0.w) * w2[6] + bfhi(a0.w) * w2[7];
              x += bflo(a1.x) * w2[8] + bfhi(a1.x) * w2[9] + bflo(a1.y) * w2[10] + bfhi(a1.y) * w2[11];
              x += bflo(a1.z) * w2[12] + bfhi(a1.z) * w2[13] + bflo(a1.w) * w2[14] + bfhi(a1.w) * w2[15];
              const float ex = __builtin_amdgcn_exp2f(-fabsf(x) * L2E);
              g = (fminf(x, 0.f) - __builtin_amdgcn_logf(1.f + ex) * LN2) * 0.0625f;
            } else {
              qv = qr / (1.f + __builtin_amdgcn_exp2f(-qr * L2E)) * 0.08838834764831845f;
              const float sg = 1.f / (1.f + __builtin_amdgcn_exp2f(-kr * L2E));
              const float fg = lb + (1.f - lb) * sg;
              kv = 1.f - fg;
              g = __builtin_amdgcn_logf(fg) * LN2;
            }
            if (t >= nvalid) { qv = 0.f; kv = 0.f; g = 0.f; }
            b += g;
            qs[t * 264 + c] = f2bf(qv * __builtin_amdgcn_exp2f(b * L2E));
            kb[q] = f2bf(kv * __builtin_amdgcn_exp2f(fminf(-b, 80.f) * L2E));
            ks[t * 264 + c] = kb[q];
          }
          pk[e] = (u32)kb[0] | ((u32)kb[1] << 16);
        }
        u32x4 o = {pk[0], pk[1], pk[2], pk[3]};
        *reinterpret_cast<u32x4*>(kfb + ((size_t)((t8 >> 1) * 64 + (t8 & 1) * 32)) * 8) = o;
      }
    }
    DL[(size_t)item * KH + kk] = __builtin_amdgcn_exp2f(b * L2E);
    __syncthreads();
    for (int jb = wvl; jb < HPB * 4; jb += 4) {
      const int hl = jb >> 2, tr = (jb >> 1) & 1, tc = jb & 1;
      f32x16 acc = zero16();
      if (!(tr == 0 && tc == 1)) {
#pragma unroll
        for (int s = 0; s < KH / 16; ++s) {
          bf16x8 a = ld16(qs + (tr * 32 + l31) * 264 + hl * KH + s * 16 + hh * 8);
          bf16x8 bb = ld16(ks + (tc * 32 + l31) * 264 + hl * KH + s * 16 + hh * 8);
          acc = MFMA(a, bb, acc);
        }
      }
      u16* am = AF + (size_t)(cgk * H + hg * HPB + hl) * 4096;
      const int scol = tc * 32 + l31;
      const int s16 = scol >> 4, hs = (scol >> 3) & 1, jj = scol & 7;
#pragma unroll
      for (int reg = 0; reg < 16; ++reg) {
        const int tl = crow(reg, hh), t = tr * 32 + tl;
        am[((tr * 4 + s16) * 64 + hs * 32 + tl) * 8 + jj] = f2bf(scol <= t ? acc[reg] : 0.f);
      }
    }
#pragma unroll
    for (int i = 0; i < 8; ++i) {
      const int f = c + 256 * i, fl = f & 63, fi = f >> 6;
      const int mt = fi & 1, s = (fi >> 1) & 1, ktg = fi >> 2;
      const int hl = ktg / KTH, kt = ktg % KTH;
      const int t = mt * 32 + (fl & 31), fh = fl >> 5;
      const u16* src = qs + t * 264 + ktg * 32 + 16 * s + 4 * fh;
      const bf16x8 v = ld8x2(src, src + 8);
      *reinterpret_cast<bf16x8*>(QF + (size_t)(cgk * H + hg * HPB + hl) * 64 * KH + ((size_t)(((kt * 2 + s) * 2 + mt) * 64 + fl)) * 8) = v;
    }
#pragma unroll 1
    for (int pc = 0; pc < HPB * VH / 256; ++pc) {
      __syncthreads();
      {
        const u16* vsrc = proj + row0 * LD + C::VOFF + (hg * HPB) * VH + pc * 256;
#pragma unroll
        for (int i = 0; i < 8; ++i) {
          const int id = c + 256 * i, t = id >> 5, ch = id & 31;
          u32x4 vv = {0u, 0u, 0u, 0u};
          if (t < nvalid) vv = __builtin_nontemporal_load(reinterpret_cast<const u32x4*>(vsrc + (size_t)t * LD + ch * 8));
          *reinterpret_cast<u32x4*>(qs + t * 264 + ch * 8) = vv;
        }
      }
      __syncthreads();
      const int cv = pc * 256 + c;
      const int hl = cv / VH, v = cv % VH;
      u16* dst = VF + (size_t)(cgk * H + hg * HPB + hl) * VH * 64 + ((size_t)((v >> 5) * 4) * 64 + (v & 31)) * 8;
#pragma unroll
      for (int t8 = 0; t8 < 8; ++t8) {
        u32 pk[4];
#pragma unroll
        for (int e = 0; e < 4; ++e) {
          const int t = t8 * 8 + 2 * e;
          pk[e] = (u32)qs[t * 264 + c] | ((u32)qs[(t + 1) * 264 + c] << 16);
        }
        u32x4 o = {pk[0], pk[1], pk[2], pk[3]};
        *reinterpret_cast<u32x4*>(dst + ((size_t)((t8 >> 1) * 64 + (t8 & 1) * 32)) * 8) = o;
      }
    }
  }
}

template <int NA_> struct SeqOps { bf16x8 q[2][2]; bf16x8 k[4]; bf16x8 v[4]; bf16x8 a[NA_]; float4 dl[4]; };

template <int KIND>
DI void seq_phase(const Params& p, int j, const char* prep, u16* obuf, char* smem) {
  using C = RC<KIND>;
  constexpr int H = C::H, KH = C::KH, VH = C::VH, WPI = KH / 32, IPB = 8 / WPI, NA = 8 / WPI, NVS = VH / 32, NV = 32 / WPI;
  const u16* QF = reinterpret_cast<const u16*>(prep);
  const u16* KF = QF + C::SZQ;
  const u16* VF = KF + C::SZQ;
  const u16* AF = VF + C::SZV;
  const float* DL = reinterpret_cast<const float*>(AF + (size_t)C::NIT * 4096);
  float* red = reinterpret_cast<float*>(smem);
  const int tid = opq(threadIdx.x), lane = tid & 63, wv = __builtin_amdgcn_readfirstlane(tid >> 6), l31 = lane & 31, hh = lane >> 5;
  const int grp = wv / WPI, wg = wv % WPI, kt = wg;
  constexpr int nitems = 12 * H * NVS, nbitems = nitems / IPB;
  constexpr size_t SSZ = (size_t)H * KH * VH;
  int cnt = 0;
  for (int bitem = blockIdx.x; bitem < nbitems; bitem += gridDim.x) {
    int bsel = bitem;
    {
      constexpr int PER_BH = NVS / IPB, NBH = 4 * H, NPB = NBH * PER_BH;
      if (bitem < NPB) { const int x = bitem & 7, i = bitem >> 3; bsel = (x * (NBH / 8) + i / PER_BH) * PER_BH + i % PER_BH; }
    }
    const int it = bsel * IPB + grp;
    const int seq = it / (H * NVS), rem = it % (H * NVS), head = rem / NVS, vs = rem % NVS;
    const size_t sbase = (size_t)head * KH * VH + (size_t)(kt * 32) * VH + vs * 32 + l31;
    float* st_out;
    if (KIND == 0) st_out = seq < 4 ? p.out + OFF_GSP + (size_t)(j * 4 + seq) * SSZ : p.out + OFF_GSS + (size_t)(j * 8 + seq - 4) * SSZ;
    else st_out = seq < 4 ? p.out + OFF_HSP + (size_t)seq * SSZ : p.out + OFF_HSS + (size_t)(seq - 4) * SSZ;
    f32x16 S;
    if (seq >= 4) {
      const float* st_in = (KIND == 0 ? p.state_gla + (size_t)j * 8 * SSZ : p.state_hgrn) + (size_t)(seq - 4) * SSZ;
#pragma unroll
      for (int reg = 0; reg < 16; ++reg) S[reg] = st_in[sbase + (size_t)crow(reg, hh) * VH];
    } else {
      S = zero16();
    }
    const int nch = seq < 4 ? 64 : 1;
    const int cg0 = seq < 4 ? seq * 64 : 256 + seq - 4;
    const int nvalid = seq < 4 ? 64 : 32;
    SeqOps<NA> cur, nxt;
    auto load_ops = [&](SeqOps<NA>& o, int cgk) {
      const size_t item = (size_t)cgk * H + head;
      const u16* qb = QF + item * 64 * KH + (size_t)(kt * 4) * 512 + lane * 8;
#pragma unroll
      for (int s = 0; s < 2; ++s)
#pragma unroll
        for (int mt = 0; mt < 2; ++mt) o.q[s][mt] = ld16(qb + (s * 2 + mt) * 512);
      const u16* kb = KF + item * 64 * KH + (size_t)(kt * 4) * 512 + lane * 8;
#pragma unroll
      for (int s16 = 0; s16 < 4; ++s16) o.k[s16] = ld16(kb + s16 * 512);
      const u16* vb = VF + item * VH * 64 + (size_t)(vs * 4) * 512 + lane * 8;
#pragma unroll
      for (int s16 = 0; s16 < 4; ++s16) o.v[s16] = ld16(vb + s16 * 512);
#pragma unroll
      for (int i = 0; i < NA; ++i) o.a[i] = ld16(AF + item * 4096 + (size_t)(wg * NA + i) * 512 + lane * 8);
      const float* db = DL + item * KH + kt * 32 + 4 * hh;
#pragma unroll
      for (int g4 = 0; g4 < 4; ++g4) o.dl[g4] = *reinterpret_cast<const float4*>(db + 8 * g4);
    };
    load_ops(cur, cg0);
    constexpr bool DEFER = true;
    u32 osum[NV / 2];
    auto store_o = [&](size_t prow0) {
#pragma unroll
      for (int i = 0; i < NV; ++i) {
        const int vec = wg * NV + i;
        const int t = (vec >> 4) * 32 + crow(vec & 15, hh);
        if (t < nvalid) obuf[(prow0 + t) * DM + head * VH + vs * 32 + l31] = (u16)((i & 1) ? (osum[i >> 1] >> 16) : (osum[i >> 1] & 0xffffu));
      }
    };
    for (int ch = 0; ch < nch; ++ch) {
      if (DEFER && ch > 0) store_o((size_t)(cg0 + ch - 1) * 64);
      if (ch + 1 < nch) load_ops(nxt, cg0 + ch + 1);
      const size_t row0 = seq < 4 ? (size_t)(cg0 + ch) * 64 : (size_t)PROWS + (size_t)(seq - 4) * 32;
      f32x16 O[2]; O[0] = zero16(); O[1] = zero16();
      {
        const bf16x8 b0 = packacc<0>(S), b1 = packacc<1>(S);
        O[0] = MFMA(cur.q[0][0], b0, O[0]);
        O[1] = MFMA(cur.q[0][1], b0, O[1]);
        O[0] = MFMA(cur.q[1][0], b1, O[0]);
        O[1] = MFMA(cur.q[1][1], b1, O[1]);
      }
#pragma unroll
      for (int i = 0; i < NA; ++i) {
        const int pi = wg * NA + i;
#pragma unroll
        for (int mc = 0; mc < 2; ++mc)
#pragma unroll
          for (int sc = 0; sc < 4; ++sc)
            if (pi == mc * 4 + sc) O[mc] = MFMA(cur.a[i], cur.v[sc], O[mc]);
      }
      u32* rp = reinterpret_cast<u32*>(red) + ((size_t)((cnt & 1) * 8 + wv) * 16) * 64 + lane;
#pragma unroll
      for (int mt = 0; mt < 2; ++mt)
#pragma unroll
        for (int r2 = 0; r2 < 8; ++r2) rp[(mt * 8 + r2) * 64] = pack2(O[mt][2 * r2], O[mt][2 * r2 + 1]);
#pragma unroll
      for (int s16 = 0; s16 < 4; ++s16) S = MFMA(cur.k[s16], cur.v[s16], S);
#pragma unroll
      for (int g4 = 0; g4 < 4; ++g4) {
        S[4 * g4 + 0] *= cur.dl[g4].x; S[4 * g4 + 1] *= cur.dl[g4].y; S[4 * g4 + 2] *= cur.dl[g4].z; S[4 * g4 + 3] *= cur.dl[g4].w;
      }
      asm volatile("s_waitcnt lgkmcnt(0)" ::: "memory");
      __builtin_amdgcn_s_barrier();
      asm volatile("" ::: "memory");
      {
        const u32* rg = reinterpret_cast<const u32*>(red) + ((size_t)((cnt & 1) * 8 + grp * WPI) * 16) * 64 + lane;
#pragma unroll
        for (int i = 0; i < NV; i += 2) {
          float sum0 = 0.f, sum1 = 0.f;
#pragma unroll
          for (int w2 = 0; w2 < WPI; ++w2) { const u32 pk = rg[((size_t)w2 * 16 + (wg * NV + i) / 2) * 64]; sum0 += bflo(pk); sum1 += bfhi(pk); }
          osum[i >> 1] = pack2(sum0, sum1);
        }
        if (!DEFER) store_o(row0);
      }
      ++cnt;
      if (ch + 1 < nch) cur = nxt;
    }
    if (DEFER) store_o(seq < 4 ? (size_t)(cg0 + nch - 1) * 64 : (size_t)PROWS + (size_t)(seq - 4) * 32);
#pragma unroll
    for (int reg = 0; reg < 16; ++reg) st_out[sbase + (size_t)crow(reg, hh) * VH] = S[reg];
  }
}

DI void gate_phase(u16* hb, const u16* proj, int ld, int zoff, const float* w, int G, float scale) {
  const int tid = opq(threadIdx.x); const int lane = tid & 63, wv = tid >> 6;
  for (int row = blockIdx.x * 8 + wv; row < MROWS; row += gridDim.x * 8) {
    u32x2* hp = reinterpret_cast<u32x2*>(hb + (size_t)row * DM);
    const u32x2* zp = reinterpret_cast<const u32x2*>(proj + (size_t)row * ld + zoff);
    float o[8][4], ss[8];
#pragma unroll
    for (int i = 0; i < 8; ++i) {
      const u32x2 pk = hp[i * 64 + lane];
      o[i][0] = bflo(pk.x); o[i][1] = bfhi(pk.x); o[i][2] = bflo(pk.y); o[i][3] = bfhi(pk.y);
      ss[i] = o[i][0] * o[i][0] + o[i][1] * o[i][1] + o[i][2] * o[i][2] + o[i][3] * o[i][3];
    }
#pragma unroll
    for (int i = 0; i < 8; ++i) ss[i] = wave_sum(ss[i]);
    if (G == 512) {
#pragma unroll
      for (int i = 0; i < 8; i += 2) { const float t = ss[i] + ss[i + 1]; ss[i] = t; ss[i + 1] = t; }
    } else if (G == 2048) {
      float t = 0.f;
#pragma unroll
      for (int i = 0; i < 8; ++i) t += ss[i];
#pragma unroll
      for (int i = 0; i < 8; ++i) ss[i] = t;
    }
    const float invG = 1.f / (float)G;
#pragma unroll
    for (int i = 0; i < 8; ++i) {
      const float r = rsqrtf(ss[i] * invG + 1e-6f) * scale;
      const int col = i * 256 + lane * 4;
      const float4 ww = *reinterpret_cast<const float4*>(w + (col & (G - 1)));
      const u32x2 zk = __builtin_nontemporal_load(zp + i * 64 + lane);
      const float z0 = bflo(zk.x), z1 = bfhi(zk.x), z2 = bflo(zk.y), z3 = bfhi(zk.y);
      const float g0 = o[i][0] * r * ww.x * (z0 / (1.f + expf(-z0)));
      const float g1 = o[i][1] * r * ww.y * (z1 / (1.f + expf(-z1)));
      const float g2 = o[i][2] * r * ww.z * (z2 / (1.f + expf(-z2)));
      const float g3 = o[i][3] * r * ww.w * (z3 / (1.f + expf(-z3)));
      u32x2 ov = {pack2(g0, g1), pack2(g2, g3)};
      hp[i * 64 + lane] = ov;
    }
  }
}

constexpr size_t SZ_VTP = (size_t)4 * 8 * 256 * 4096;
constexpr size_t SZ_KS = (size_t)8 * 16 * 1088 * 128;
DI void diffprep_cache(const Params& p, char* prep, int rank, int nranks) {
  u16* VTP = reinterpret_cast<u16*>(prep);
  u16* KS = VTP + SZ_VTP;
  u16* VTS = KS + SZ_KS;
  const int tid0 = opq(threadIdx.x), half = tid0 >> 8, tid = tid0 & 255;
  for (int it = rank * 2 + half; it < 8 * 8 * 16; it += nranks * 2) {
    const int kt = it & 15, bh = it >> 4, b = bh >> 3, h = bh & 7;
    u16* dst = VTS + ((size_t)((b * 8 + h) * 256 + tid)) * 1088 + kt * 64;
    const float* src = p.cache_v + ((size_t)(b * 1024 + kt * 64) * 8 + h) * 256 + tid;
#pragma unroll
    for (int g16 = 0; g16 < 4; ++g16) {
      float v[16];
#pragma unroll
      for (int e = 0; e < 16; ++e) v[e] = __builtin_nontemporal_load(src + (size_t)(g16 * 16 + e) * 2048);
      u32x4 o0 = {pack2(v[0], v[1]), pack2(v[2], v[3]), pack2(v[8], v[9]), pack2(v[10], v[11])};
      u32x4 o1 = {pack2(v[4], v[5]), pack2(v[6], v[7]), pack2(v[12], v[13]), pack2(v[14], v[15])};
      *reinterpret_cast<u32x4*>(dst + g16 * 16) = o0;
      *reinterpret_cast<u32x4*>(dst + g16 * 16 + 8) = o1;
    }
  }
  const int nchunks = 8 * 16 * 1024 * 16;
  for (int id = rank * 512 + tid0; id < nchunks; id += nranks * 512) {
    const int d8 = id & 15, rest = id >> 4, key = rest & 1023, bn = rest >> 10, b = bn >> 4, n = bn & 15;
    const float4* sp = reinterpret_cast<const float4*>(p.cache_k + ((size_t)(b * 1024 + key) * 16 + n) * 128 + d8 * 8);
    const float4 a = sp[0], c = sp[1];
    u32x4 o = {pack2(a.x, a.y), pack2(a.z, a.w), pack2(c.x, c.y), pack2(c.z, c.w)};
    *reinterpret_cast<u32x4*>(KS + ((size_t)(b * 16 + n) * 1088 + key) * 128 + d8 * 8) = o;
  }
}
DI void diffprep_phase(const Params& p, const u16* proj, char* prep, char* smem) {
  u16* VTP = reinterpret_cast<u16*>(prep);
  u16* KS = VTP + SZ_VTP;
  u16* VTS = KS + SZ_KS;
  const int tid0 = opq(threadIdx.x), half = tid0 >> 8, tid = tid0 & 255;
  u16* tl = reinterpret_cast<u16*>(smem) + half * (64 * 264);
  for (int it = blockIdx.x * 2 + half; it < 2048; it += gridDim.x * 2) {
    const int h = it & 7, c = (it >> 3) & 63, b = it >> 9;
    const u16* src = proj + (size_t)(b * 4096 + c * 64) * 8192 + 4096 + h * 256;
    __syncthreads();
#pragma unroll
    for (int i = 0; i < 8; ++i) {
      const int id = tid + 256 * i, t = id >> 5, ch = id & 31;
      *reinterpret_cast<u32x4*>(tl + t * 264 + ch * 8) = __builtin_nontemporal_load(reinterpret_cast<const u32x4*>(src + (size_t)t * 8192 + ch * 8));
    }
    __syncthreads();
    u16* dst = VTP + ((size_t)((b * 8 + h) * 256 + tid)) * 4096 + c * 64;
#pragma unroll
    for (int g16 = 0; g16 < 4; ++g16) {
      u32 pk[8];
#pragma unroll
      for (int e = 0; e < 8; ++e) {
        const int t = g16 * 16 + 2 * e;
        pk[e] = (u32)tl[t * 264 + tid] | ((u32)tl[(t + 1) * 264 + tid] << 16);
      }
      u32x4 o0 = {pk[0], pk[1], pk[4], pk[5]}, o1 = {pk[2], pk[3], pk[6], pk[7]};
      *reinterpret_cast<u32x4*>(dst + g16 * 16) = o0;
      *reinterpret_cast<u32x4*>(dst + g16 * 16 + 8) = o1;
    }
  }
  for (int it = blockIdx.x * 2 + half; it < 8 * 8; it += gridDim.x * 2) {
    const int b = it >> 3, h = it & 7;
    u16* dst = VTS + ((size_t)((b * 8 + h) * 256 + tid)) * 1088 + 16 * 64;
#pragma unroll
    for (int g16 = 0; g16 < 4; ++g16) {
      u32 pk[8];
#pragma unroll
      for (int e = 0; e < 8; ++e) {
        const int k0 = g16 * 16 + 2 * e;
        const u32 lo = k0 < 32 ? (u32)proj[(size_t)(PROWS + b * 32 + k0) * 8192 + 4096 + h * 256 + tid] : 0u;
        const u32 hi = k0 + 1 < 32 ? (u32)proj[(size_t)(PROWS + b * 32 + k0 + 1) * 8192 + 4096 + h * 256 + tid] : 0u;
        pk[e] = lo | (hi << 16);
      }
      u32x4 o0 = {pk[0], pk[1], pk[4], pk[5]}, o1 = {pk[2], pk[3], pk[6], pk[7]};
      *reinterpret_cast<u32x4*>(dst + g16 * 16) = o0;
      *reinterpret_cast<u32x4*>(dst + g16 * 16 + 8) = o1;
    }
  }
  const int nchunks = 8 * 16 * 64 * 16;
  for (int id = blockIdx.x * 512 + tid0; id < nchunks; id += gridDim.x * 512) {
    const int d8 = id & 15, rest = id >> 4, kl = rest & 63, bn = rest >> 6, b = bn >> 4, n = bn & 15;
    u32x4 o = {0u, 0u, 0u, 0u};
    if (kl < 32) o = *reinterpret_cast<const u32x4*>(proj + (size_t)(PROWS + b * 32 + kl) * 8192 + 2048 + n * 128 + d8 * 8);
    *reinterpret_cast<u32x4*>(KS + ((size_t)(b * 16 + n) * 1088 + 1024 + kl) * 128 + d8 * 8) = o;
  }
}

DI void attn_phase(const Params& p, const u16* proj, const char* prep, u16* obuf, char* smem) {
  const u16* VTP = reinterpret_cast<const u16*>(prep);
  const u16* KS = VTP + SZ_VTP;
  const u16* VTS = KS + SZ_KS;
  constexpr int BUFE = 2 * 64 * 136 + 256 * 72;
  u16* lds = reinterpret_cast<u16*>(smem);
  float* Ot = reinterpret_cast<float*>(smem);
  const int tid = opq(threadIdx.x), lane = tid & 63, wv = __builtin_amdgcn_readfirstlane(tid >> 6), l31 = lane & 31, hh = lane >> 5;
  const int qt = wv & 1, jh = (wv >> 1) & 1, vh = wv >> 2;
  const int G = gridDim.x;
  bool xcdmap = (G == 256);
  int xx = (int)blockIdx.x & 7, yy = (int)blockIdx.x >> 3;
  if (xcdmap) {
    const unsigned* bar = reinterpret_cast<const unsigned*>(p.ws + WS_BAR);
    bool even = true;
#pragma unroll
    for (int jx = 0; jx < 8; ++jx) even = even && (bar[256 + 64 * jx] == 32u);
    if (even) {
      const unsigned sl = reinterpret_cast<volatile unsigned*>(smem + LDS_BYTES - 16)[2];
      xx = (int)(sl >> 16) & 7; yy = (int)(sl & 31u);
    }
  }
  xx = __builtin_amdgcn_readfirstlane(xx); yy = __builtin_amdgcn_readfirstlane(yy);
  const int nrounds = xcdmap ? 9 : (2048 + 64 + G - 1) / G;
  for (int r = 0; r < nrounds; ++r) {
    int i;
    if (xcdmap) {
      const int x = xx, y = yy;
      if (r < 8) { const int bh = x * 4 + (r >> 1), c = (r & 1) ? y : 63 - y; i = ((63 - c) << 5) | bh; }
      else { i = (x * 32 + y) < 64 ? 2048 + (x * 32 + y) : 1 << 30; }
    } else {
      i = r * G + (int)blockIdx.x;
    }
    if (i >= 2048 + 64) continue;
    int b, h, nt, nkeys, nq; size_t qrow0, kstride, khs, vtstride; const u16* kbase; const u16* vtbase;
    if (i < 2048) {
      const int c = 63 - (i >> 5), bh = i & 31; b = bh >> 3; h = bh & 7; nt = c + 1; nkeys = nt * 64; nq = 64;
      qrow0 = (size_t)b * 4096 + c * 64;
      kbase = proj + (size_t)(b * 4096) * 8192 + 2048 + (2 * h) * 128; kstride = 8192; khs = 128;
      vtbase = VTP + (size_t)((b * 8 + h) * 256) * 4096; vtstride = 4096;
    } else {
      const int bh = i - 2048; b = bh >> 3; h = bh & 7; nt = 17; nkeys = 1056; nq = 32;
      qrow0 = (size_t)PROWS + b * 32;
      kbase = KS + (size_t)((b * 16 + 2 * h) * 1088) * 128; kstride = 128; khs = (size_t)1088 * 128;
      vtbase = VTS + (size_t)((b * 8 + h) * 256) * 1088; vtstride = 1088;
    }
    bf16x8 Qf[8];
    {
      const size_t qrow = qrow0 + ((qt * 32 < nq) ? qt * 32 : 0) + l31;
      const u16* qp = proj + qrow * 8192 + (2 * h + jh) * 128 + hh * 8;
#pragma unroll
      for (int s = 0; s < 8; ++s) Qf[s] = ld16(qp + s * 16);
#pragma unroll
      for (int s = 0; s < 8; ++s) asm volatile("" : "+v"(Qf[s]));
    }
    u32x4 kr[4], vr[4];
    auto gload = [&](int kt) {
#pragma unroll
      for (int ii = 0; ii < 4; ++ii) {
        const int id = tid + 512 * ii;
        const int jl = id >> 10, key = (id >> 4) & 63, ch = id & 15;
        kr[ii] = *reinterpret_cast<const u32x4*>(kbase + jl * khs + (size_t)(kt * 64 + key) * kstride + ch * 8);
        const int vd = id >> 3, cv = id & 7;
        vr[ii] = *reinterpret_cast<const u32x4*>(vtbase + (size_t)vd * vtstride + kt * 64 + cv * 8);
      }
    };
    auto sstore = [&](int buf) {
      u16* Ks = lds + buf * BUFE; u16* Vt = Ks + 2 * 64 * 136;
#pragma unroll
      for (int ii = 0; ii < 4; ++ii) {
        const int id = tid + 512 * ii;
        const int jl = id >> 10, key = (id >> 4) & 63, ch = id & 15;
        *reinterpret_cast<u32x4*>(Ks + (jl * 64 + key) * 136 + ch * 8) = kr[ii];
        const int vd = id >> 3, cv = id & 7;
        *reinterpret_cast<u32x4*>(Vt + vd * 72 + cv * 8) = vr[ii];
      }
    };
    float m = -1e30f, l = 0.f;
    f32x16 O[4];
#pragma unroll
    for (int vt = 0; vt < 4; ++vt) O[vt] = zero16();
#define ATT_BAR() do { asm volatile("s_waitcnt lgkmcnt(0)" ::: "memory"); __builtin_amdgcn_s_barrier(); asm volatile("" ::: "memory"); } while (0)
    const bool grpB = vh != 0;
    gload(0);
    __syncthreads();
    sstore(0);
    __syncthreads();
    if (nt > 1) gload(1);
    if (grpB) ATT_BAR();
    for (int kt = 0; kt < nt; ++kt) {
      const u16* Ks = lds + (kt & 1) * BUFE; const u16* Vt = Ks + 2 * 64 * 136;
      f32x16 st[2];
      __builtin_amdgcn_s_setprio(1);
#pragma unroll
      for (int kti = 0; kti < 2; ++kti) {
        st[kti] = zero16();
#pragma unroll
        for (int s = 0; s < 8; ++s) {
          const bf16x8 a = ld16(Ks + (jh * 64 + kti * 32 + l31) * 136 + s * 16 + hh * 8);
          st[kti] = MFMA(a, Qf[s], st[kti]);
        }
      }
      __builtin_amdgcn_s_setprio(0);
      constexpr float SC = 0.08838834764831845f * 1.4426950408889634f;
      if ((kt + 1) * 64 > nkeys) {
#pragma unroll
        for (int kti = 0; kti < 2; ++kti)
#pragma unroll
          for (int reg = 0; reg < 16; ++reg)
            if (kt * 64 + kti * 32 + crow(reg, hh) >= nkeys) st[kti][reg] = -1e30f;
      }
      float mx = -1e30f;
#pragma unroll
      for (int kti = 0; kti < 2; ++kti)
#pragma unroll
        for (int reg = 0; reg < 16; ++reg) mx = fmaxf(mx, st[kti][reg]);
      mx = fmaxf(mx, __shfl_xor(mx, 32)) * SC;
      const bool bump = __any(mx > m + 8.f);
      const float mn = bump ? fmaxf(m, mx) : m;
      float rs = 0.f;
#pragma unroll
      for (int kti = 0; kti < 2; ++kti)
#pragma unroll
        for (int reg = 0; reg < 16; ++reg) {
          const float pv = __builtin_amdgcn_exp2f(st[kti][reg] * SC - mn);
          st[kti][reg] = pv; rs += pv;
        }
      rs += __shfl_xor(rs, 32);
      if (bump) {
        const float alpha = __builtin_amdgcn_exp2f(m - mn);
        l *= alpha;
#pragma unroll
        for (int vt = 0; vt < 4; ++vt)
#pragma unroll
          for (int reg = 0; reg < 16; ++reg) O[vt][reg] *= alpha;
      }
      l += rs; m = mn;
      if (grpB && kt + 1 < nt) { sstore((kt + 1) & 1); if (kt + 2 < nt) gload(kt + 2); }
      ATT_BAR();
      __builtin_amdgcn_s_setprio(1);
#pragma unroll
      for (int kti = 0; kti < 2; ++kti) {
        {
          const bf16x8 pf = packacc<0>(st[kti]);
#pragma unroll
          for (int vt = 0; vt < 4; ++vt) {
            O[vt] = MFMA(ld16(Vt + ((vh * 4 + vt) * 32 + l31) * 72 + kti * 32 + 8 * hh), pf, O[vt]);
          }
        }
        {
          const bf16x8 pf = packacc<1>(st[kti]);
#pragma unroll
          for (int vt = 0; vt < 4; ++vt) {
            O[vt] = MFMA(ld16(Vt + ((vh * 4 + vt) * 32 + l31) * 72 + kti * 32 + 16 + 8 * hh), pf, O[vt]);
          }
        }
      }
      __builtin_amdgcn_s_setprio(0);
      if (!grpB && kt + 1 < nt) { sstore((kt + 1) & 1); if (kt + 2 < nt) gload(kt + 2); }
      ATT_BAR();
    }
    if (!grpB) ATT_BAR();
#undef ATT_BAR
    const float inv = 1.f / l;
    float lam;
    {
      const float* lp = p.diff_lambda;
      float s1 = lp[lane] * lp[128 + lane] + lp[64 + lane] * lp[192 + lane];
      float s2 = lp[256 + lane] * lp[384 + lane] + lp[320 + lane] * lp[448 + lane];
      s1 = wave_sum(s1); s2 = wave_sum(s2);
      lam = expf(s1) - expf(s2) + LAM_INIT;
    }
    if (jh == 1) {
#pragma unroll
      for (int vt = 0; vt < 4; ++vt)
#pragma unroll
        for (int reg = 0; reg < 16; ++reg) Ot[(qt * 32 + l31) * 257 + (vh * 4 + vt) * 32 + crow(reg, hh)] = lam * O[vt][reg] * inv;
    }
    __syncthreads();
    if (jh == 0) {
#pragma unroll
      for (int vt = 0; vt < 4; ++vt)
#pragma unroll
        for (int reg = 0; reg < 16; ++reg) {
          const int idx = (qt * 32 + l31) * 257 + (vh * 4 + vt) * 32 + crow(reg, hh);
          Ot[idx] = O[vt][reg] * inv - Ot[idx];
        }
    }
    __syncthreads();
    {
#pragma unroll 1
      for (int rr = 0; rr < 8; ++rr) {
        const int q = wv * 8 + rr;
        const float a0 = Ot[q * 257 + lane], a1 = Ot[q * 257 + 64 + lane], a2 = Ot[q * 257 + 128 + lane], a3 = Ot[q * 257 + 192 + lane];
        float ss = wave_sum(a0 * a0 + a1 * a1 + a2 * a2 + a3 * a3);
        if (lane == 0) Ot[q * 257 + 256] = rsqrtf(ss * (1.f / 256.f) + 1e-6f) * (1.f - LAM_INIT);
      }
    }
    __syncthreads();
    {
      u32 zk[16];
      const int te = opq(tid);
#pragma unroll
      for (int ii = 0; ii < 16; ++ii) {
        const int id = te + 512 * ii, q = id >> 7, vd = (id & 127) * 2;
        zk[ii] = *reinterpret_cast<const u32*>(proj + (qrow0 + (q < nq ? q : 0)) * 8192 + 6144 + h * 256 + vd);
      }
      const int vd0 = (te & 127) * 2;
      const float w0 = p.diff_subln_w[vd0], w1 = p.diff_subln_w[vd0 + 1];
#pragma unroll
      for (int ii = 0; ii < 16; ++ii) {
        const int id = te + 512 * ii, q = id >> 7, vd = (id & 127) * 2;
        if (q < nq) {
          const float r = Ot[q * 257 + 256];
          const float z0 = bflo(zk[ii]), z1 = bfhi(zk[ii]);
          const float g0 = Ot[q * 257 + vd] * r * w0 * (z0 / (1.f + __builtin_amdgcn_exp2f(-z0 * 1.4426950408889634f)));
          const float g1 = Ot[q * 257 + vd + 1] * r * w1 * (z1 / (1.f + __builtin_amdgcn_exp2f(-z1 * 1.4426950408889634f)));
          *reinterpret_cast<u32*>(obuf + (qrow0 + q) * DM + h * 256 + vd) = pack2(g0, g1);
        }
      }
    }
  }
}

#define XB_TMO      128
#define XB_XCNT(j)  (256  + 64 * (j))
#define XB_XSUB(j)  (1280 + 64 * (j))
#define XB_XGEN(j)  (2304 + 64 * (j))
#define XB_TOP      3328
#define XB_TOPGEN   3392
#define XCD_BAR_WORDS 3456
#define XB_SPIN_CAP (1u << 18)
DI unsigned xb_ld(unsigned* p) { return __hip_atomic_load(p, __ATOMIC_RELAXED, __HIP_MEMORY_SCOPE_AGENT); }
DI unsigned xb_add(unsigned* p, unsigned v) { return __hip_atomic_fetch_add(p, v, __ATOMIC_RELAXED, __HIP_MEMORY_SCOPE_AGENT); }
DI unsigned xb_xcc_id() { return (unsigned)__builtin_amdgcn_s_getreg((3 << 11) | 20) & 0xFu; }
#define XB_SPIN(cond, bar) do { unsigned _sp = 0; while (cond) { __builtin_amdgcn_s_sleep(1); \
    if ((++_sp & 255u) == 0u) { if (xb_ld(&(bar)[XB_TMO])) break; if (_sp > XB_SPIN_CAP) { atomicAdd(&(bar)[XB_TMO], 1u); break; } } } } while (0)
struct XcdBarrier { unsigned* bar; unsigned x; volatile LAS unsigned* st; };
DI XcdBarrier xcd_barrier_post(unsigned* bar, volatile LAS unsigned* st) {
  XcdBarrier b; b.bar = bar; b.x = xb_xcc_id(); b.st = st;
  if (threadIdx.x == 0) (void)xb_add(&bar[XB_XCNT(b.x)], 1u);
  return b;
}
DI void xcd_barrier_complete(unsigned* bar, unsigned x, unsigned& nloc, unsigned& nx) {
  const unsigned G = gridDim.x * gridDim.y * gridDim.z;
  unsigned sum, cnt, mine, sp = 0u;
  for (;;) {
    sum = 0u; cnt = 0u; mine = 0u;
#pragma unroll
    for (unsigned j = 0; j < 16; ++j) { const unsigned c = xb_ld(&bar[XB_XCNT(j)]); sum += c; cnt += (c > 0u) ? 1u : 0u; mine = (j == x) ? c : mine; }
    if (sum == G) break;
    __builtin_amdgcn_s_sleep(1);
    if ((++sp & 255u) == 0u) { if (xb_ld(&bar[XB_TMO])) break; if (sp > XB_SPIN_CAP) { atomicAdd(&bar[XB_TMO], 1u); break; } }
  }
  nloc = mine > 0u ? mine : 1u; nx = cnt > 0u ? cnt : 1u;
}
DI void xcd_barrier(const XcdBarrier& b) {
  asm volatile("s_waitcnt vmcnt(0)" ::: "memory");
  __syncthreads();
  if (threadIdx.x == 0) {
    unsigned* bar = b.bar;
    __builtin_amdgcn_s_waitcnt(0);
    unsigned nloc = b.st[0], nx = b.st[1];
    if (nloc == 0u) { xcd_barrier_complete(bar, b.x, nloc, nx); b.st[0] = nloc; b.st[1] = nx; }
    const unsigned old = xb_add(&bar[XB_XSUB(b.x)], 1u);
    const unsigned gen = old / nloc;
    if (old + 1u == (gen + 1u) * nloc) {
      __builtin_amdgcn_fence(__ATOMIC_RELEASE, "agent");
      asm volatile("s_waitcnt vmcnt(0)" ::: "memory");
      const unsigned og = xb_add(&bar[XB_TOP], 1u);
      const unsigned tg = og / nx;
      if (og + 1u == (tg + 1u) * nx) xb_add(&bar[XB_TOPGEN], 1u);
      else XB_SPIN(xb_ld(&bar[XB_TOPGEN]) == tg, bar);
      __builtin_amdgcn_fence(__ATOMIC_ACQUIRE, "agent");
      xb_add(&bar[XB_XGEN(b.x)], 1u);
      asm volatile("s_waitcnt vmcnt(0)" ::: "memory");
    } else {
      XB_SPIN(xb_ld(&bar[XB_XGEN(b.x)]) == gen, bar);
      __builtin_amdgcn_fence(__ATOMIC_ACQUIRE, "agent");
      asm volatile("s_waitcnt vmcnt(0)" ::: "memory");
    }
  }
  __syncthreads();
}

typedef const __attribute__((address_space(4))) Params* KPtr;
#if defined(__HIP_DEVICE_COMPILE__)
DI Params KP() { KPtr q = (KPtr)__builtin_amdgcn_kernarg_segment_ptr(); asm volatile("" : "+s"(q)); return *q; }
#else
DI Params KP() { return Params{}; }
#endif

DI void gsync(const Params& p, char* smem) {
  unsigned long long ba = reinterpret_cast<unsigned long long>(p.ws + WS_BAR);
  asm volatile("" : "+s"(ba));
  XcdBarrier b; b.bar = reinterpret_cast<unsigned*>(ba); b.x = xb_xcc_id();
  b.st = reinterpret_cast<volatile LAS unsigned*>((LAS unsigned char*)smem + LDS_BYTES - 16);
  xcd_barrier(b);
}

template <int LAYER>
DI void conv_layer(const Params& p, u16* WIN, u16* wout, int rank, int nranks) {
  constexpr int kind = LAYER % 3, j = LAYER / 3;
  if (kind == 0) {
    conv_job(p.gla_w_in + (size_t)j * 2048 * 6144, 6144, 6144, WIN, 0, rank, nranks);
    conv_job(p.gla_w_a1 + (size_t)j * 2048 * 16, 16, 16, WIN, 6144, rank, nranks);
    for (int id = rank * 512 + opq(threadIdx.x); id < 240 * 256; id += nranks * 512) {
      u32x4 z = {0u, 0u, 0u, 0u};
      reinterpret_cast<u32x4*>(WIN + (size_t)6160 * 2048)[id] = z;
    }
    conv_job(p.gla_w_out + (size_t)j * 2048 * 2048, 2048, 2048, wout, 0, rank, nranks);
  } else if (kind == 1) {
    conv_job(p.hgrn_w_in, 8192, 8192, WIN, 0, rank, nranks);
    conv_job(p.hgrn_w_out, 2048, 2048, wout, 0, rank, nranks);
  } else {
    conv_job(p.diff_w_in, 8192, 8192, WIN, 0, rank, nranks);
    conv_job(p.diff_w_out, 2048, 2048, wout, 0, rank, nranks);
  }
}

template <int LAYER>
DI void do_layer(char* smem, cg::grid_group& grid) {
  const Params p = KP();
  constexpr int layer = LAYER, kind = LAYER % 3, j = LAYER / 3;
  u16* WIN = reinterpret_cast<u16*>(p.ws + WS_WIN);
  u16* WOUT = reinterpret_cast<u16*>(p.ws + ((layer & 1) ? WS_WOUT1 : WS_WOUT));
  u16* WOUT_NEXT = reinterpret_cast<u16*>(p.ws + ((layer & 1) ? WS_WOUT : WS_WOUT1));
  u16* HB = reinterpret_cast<u16*>(p.ws + WS_H);
  u16* PROJ = reinterpret_cast<u16*>(p.ws + WS_PROJ);
  char* PREP_WS = p.ws + WS_PREP;
  char* PREP_OUT = reinterpret_cast<char*>(p.out + OFF_KP);
  if (layer == 0) conv_layer<0>(KP(), WIN, WOUT, blockIdx.x, gridDim.x);
  float* RS = reinterpret_cast<float*>(p.ws + WS_RS);
  u16* XW = reinterpret_cast<u16*>(p.ws + WS_XW);
  if (layer == 0) {
    norm_phase(p.x_prompt, p.x_sample, p.norm_w, HB);
    for (int i = blockIdx.x * 512 + opq(threadIdx.x); i < 4 * MROWS; i += gridDim.x * 512) RS[i] = 0.f;
    grid.sync();
    (void)xcd_barrier_post(reinterpret_cast<unsigned*>(p.ws + WS_BAR), reinterpret_cast<volatile LAS unsigned*>((LAS unsigned char*)smem + LDS_BYTES - 16));
    if (threadIdx.x == 0) {
      const unsigned x = xb_xcc_id();
      const unsigned y = xb_add(reinterpret_cast<unsigned*>(p.ws + WS_BAR) + 8 * x, 1u);
      reinterpret_cast<volatile unsigned*>(smem + LDS_BYTES - 16)[2] = (x << 16) | (y & 0xffffu);
    }
  }
  {
    pg8::EpiProj E; E.O = PROJ; E.ldc = kind == 0 ? GLA_LD : 8192; E.out = p.out; E.mode = kind == 2 ? 1 : 0;
    E.rs = layer == 0 ? nullptr : RS + (layer - 1) * MROWS;
    gemm8(smem, layer == 0 ? HB : XW, WIN, kind == 0 ? GLA_LD : 8192, E);
  }
  gsync(KP(), smem);
  if (kind == 0) {
    prep_phase<0>(KP(), layer, j, PROJ, PREP_WS, smem);
    gsync(KP(), smem);
    seq_phase<0>(KP(), j, PREP_WS, HB, smem);
  } else if (kind == 1) {
    prep_phase<1>(KP(), layer, j, PROJ, PREP_OUT, smem);
    gsync(KP(), smem);
    seq_phase<1>(KP(), j, PREP_OUT, HB, smem);
    if ((int)blockIdx.x >= 128 && gridDim.x > 128) diffprep_cache(KP(), PREP_WS, (int)blockIdx.x - 128, (int)gridDim.x - 128);
    else if (gridDim.x <= 128) diffprep_cache(KP(), PREP_WS, blockIdx.x, gridDim.x);
  } else {
    diffprep_phase(KP(), PROJ, PREP_WS, smem);
    gsync(KP(), smem);
    attn_phase(KP(), PROJ, PREP_WS, HB, smem);
  }
  gsync(KP(), smem);
  if (kind == 0) gate_phase(HB, PROJ, GLA_LD, 4096, p.gla_norm_w + j * 512, 512, 1.f);
  else if (kind == 1) gate_phase(HB, PROJ, 8192, 6144, p.hgrn_norm_w, 2048, 1.f);
  if (kind != 2) gsync(KP(), smem);
  {
    pg8::EpiRes E; E.xp = p.x_prompt; E.xs = p.x_sample; E.out = p.out; E.layer = layer;
    E.wn = p.norm_w + (layer < 3 ? (layer + 1) * DM : 0); E.xw = layer < 3 ? XW : nullptr; E.rs = RS + layer * MROWS;
    gemm8(smem, HB, WOUT, 2048, E);
    if (layer < 3) {
      const int nwg = (MROWS / 256) * (2048 / 256), G = gridDim.x, R = nwg % G;
      if ((int)blockIdx.x >= R) conv_layer<(LAYER + 1) % 4>(KP(), WIN, WOUT_NEXT, (int)blockIdx.x - R, G - R);
    }
  }
  gsync(KP(), smem);
}

__global__ void __launch_bounds__(512) mega(Params p) {
  extern __shared__ __attribute__((aligned(16))) char smem[];
  cg::grid_group grid = cg::this_grid();
  {
    unsigned* bar = reinterpret_cast<unsigned*>(p.ws + WS_BAR);
    if (blockIdx.x == 0) for (int i = threadIdx.x; i < XCD_BAR_WORDS; i += 512) bar[i] = 0u;
    if (threadIdx.x < 4) reinterpret_cast<volatile unsigned*>(smem + LDS_BYTES - 16)[threadIdx.x] = 0u;
    __syncthreads();
  }
  do_layer<0>(smem, grid);
  do_layer<1>(smem, grid);
  do_layer<2>(smem, grid);
  do_layer<3>(smem, grid);
  final_norm_phase(p.out, p.final_norm_w, reinterpret_cast<const float*>(p.ws + WS_RS) + 3 * MROWS);
}

extern "C" void kernel_launch(void* const* d_in, const int* in_sizes, int n_in, void* d_out, int out_size, void* d_ws, size_t ws_size,
                              hipStream_t stream) {
  Params p{};
  p.x_prompt = (const float*)d_in[0]; p.x_sample = (const float*)d_in[1]; p.state_gla = (const float*)d_in[2]; p.state_hgrn = (const float*)d_in[3];
  p.cache_k = (const float*)d_in[4]; p.cache_v = (const float*)d_in[5]; p.norm_w = (const float*)d_in[6]; p.final_norm_w = (const float*)d_in[7];
  p.gla_w_in = (const float*)d_in[8]; p.gla_w_a1 = (const float*)d_in[9]; p.gla_w_a2 = (const float*)d_in[10]; p.gla_b_a = (const float*)d_in[11];
  p.gla_norm_w = (const float*)d_in[12]; p.gla_w_out = (const float*)d_in[13];
  p.hgrn_w_in = (const float*)d_in[14]; p.hgrn_lb = (const float*)d_in[15]; p.hgrn_norm_w = (const float*)d_in[16]; p.hgrn_w_out = (const float*)d_in[17];
  p.diff_w_in = (const float*)d_in[18]; p.diff_lambda = (const float*)d_in[19]; p.diff_subln_w = (const float*)d_in[20]; p.diff_w_out = (const float*)d_in[21];
  p.out = (float*)d_out; p.ws = (char*)d_ws;
  static int grid_blocks = 0;
  if (!grid_blocks) {
    int dev = 0, cus = 0, per_cu = 0;
    (void)hipGetDevice(&dev);
    (void)hipFuncSetAttribute((const void*)mega, hipFuncAttributeMaxDynamicSharedMemorySize, (int)LDS_BYTES);
    (void)hipDeviceGetAttribute(&cus, hipDeviceAttributeMultiprocessorCount, dev);
    (void)hipOccupancyMaxActiveBlocksPerMultiprocessor(&per_cu, mega, 512, LDS_BYTES);
    if (per_cu < 1) per_cu = 1;
    if (per_cu > 1) per_cu = 1;
    grid_blocks = cus * per_cu;
  }
  void* args[] = {&p};
  hipError_t e = hipLaunchCooperativeKernel((void*)mega, dim3(grid_blocks), dim3(512), args, LDS_BYTES, stream);
  if (e != hipSuccess) fprintf(stderr, "cooperative launch failed: %s (grid %d)\n", hipGetErrorString(e), grid_blocks);
}
```

```cpp
#include <hip/hip_runtime.h>
#include <hip/hip_cooperative_groups.h>
#include <cstdio>
namespace cg = cooperative_groups;

typedef unsigned short u16;
typedef unsigned int u32;
using bf16x8 = __attribute__((ext_vector_type(8))) short;
using f32x16 = __attribute__((ext_vector_type(16))) float;
using f32x4 = __attribute__((ext_vector_type(4))) float;
using u32x4 = __attribute__((ext_vector_type(4))) unsigned;
using u32x2 = __attribute__((ext_vector_type(2))) unsigned;

#define DI __device__ __forceinline__
#define MFMA(a, b, c) __builtin_amdgcn_mfma_f32_32x32x16_bf16((a), (b), (c), 0, 0, 0)
#define LAS __attribute__((address_space(3)))

constexpr int MROWS = 16640;
constexpr int PROWS = 16384;
constexpr int DM = 2048;
constexpr size_t OFF_GSP = 34078720;
constexpr size_t OFF_GSS = 38273024;
constexpr size_t OFF_HSP = 46661632;
constexpr size_t OFF_HSS = 47710208;
constexpr size_t OFF_KP = 49807360;
constexpr size_t OFF_VP = 83361792;
constexpr size_t OFF_KS = 116916224;
constexpr size_t OFF_VS = 117440512;
constexpr size_t WS_WIN = 0;
constexpr size_t WS_WOUT = 33554432;
constexpr size_t WS_H = 41943040;
constexpr size_t WS_PROJ = 110100480;
constexpr size_t WS_PREP = 382730240;
constexpr size_t WS_XW = 530874368;
constexpr size_t WS_BAR = 599031808;
constexpr size_t WS_RS = 599048192;
constexpr size_t WS_WOUT1 = 599314432;
constexpr size_t LDS_BYTES = 147456;
constexpr float LAM_INIT = 0.47071302f;
constexpr int GLA_LD = 6400;

struct Params {
  const float* x_prompt; const float* x_sample; const float* state_gla; const float* state_hgrn;
  const float* cache_k; const float* cache_v; const float* norm_w; const float* final_norm_w;
  const float* gla_w_in; const float* gla_w_a1; const float* gla_w_a2; const float* gla_b_a;
  const float* gla_norm_w; const float* gla_w_out;
  const float* hgrn_w_in; const float* hgrn_lb; const float* hgrn_norm_w; const float* hgrn_w_out;
  const float* diff_w_in; const float* diff_lambda; const float* diff_subln_w; const float* diff_w_out;
  float* out; char* ws;
};

typedef __bf16 bf16v2 __attribute__((ext_vector_type(2)));
typedef float f32v2 __attribute__((ext_vector_type(2)));
DI u32 pack2(float a, float b) { f32v2 v = {a, b}; return __builtin_bit_cast(u32, __builtin_convertvector(v, bf16v2)); }
DI u16 f2bf(float x) { return (u16)(pack2(x, 0.f) & 0xffffu); }
DI float bf2f(u16 b) { return __uint_as_float(((u32)b) << 16); }
DI float bflo(u32 p) { return __uint_as_float(p << 16); }
DI float bfhi(u32 p) { return __uint_as_float(p & 0xffff0000u); }
DI bf16x8 ld16(const u16* p) { return *reinterpret_cast<const bf16x8*>(p); }
DI bf16x8 ld8x2(const u16* p0, const u16* p1) {
  u32x2 a = *reinterpret_cast<const u32x2*>(p0); u32x2 b = *reinterpret_cast<const u32x2*>(p1);
  u32x4 r = {a.x, a.y, b.x, b.y}; return __builtin_bit_cast(bf16x8, r);
}
DI int opq(int x) { asm volatile("" : "+v"(x)); return x; }
DI int crow(int reg, int hh) { return (reg & 3) + 8 * (reg >> 2) + 4 * hh; }
template <int S> DI bf16x8 packacc(const f32x16& x) {
  u32x4 r = {pack2(x[8 * S], x[8 * S + 1]), pack2(x[8 * S + 2], x[8 * S + 3]), pack2(x[8 * S + 4], x[8 * S + 5]), pack2(x[8 * S + 6], x[8 * S + 7])};
  return __builtin_bit_cast(bf16x8, r);
}
DI float wave_sum(float v) {
#pragma unroll
  for (int o = 32; o > 0; o >>= 1) v += __shfl_xor(v, o);
  return v;
}
DI f32x16 zero16() { f32x16 z;
#pragma unroll
  for (int i = 0; i < 16; ++i) z[i] = 0.f;
  return z; }

DI void conv_job(const float* W, int ldw, int ncols, u16* Wt, int drow0, int rank, int nranks) {
  const int tid = opq(threadIdx.x), lane = tid & 63, wv = tid >> 6;
  const int ntn = (ncols + 63) >> 6;
  const int ntiles = 64 * ntn;
  for (int tile = rank * 8 + wv; tile < ntiles; tile += nranks * 8) {
    const int tn = tile % ntn, tk = tile / ntn;
    const int n = tn * 64 + lane, k0 = tk * 32;
    if (n < ncols) {
      const float* src = W + (size_t)k0 * ldw + n;
      float v[32];
#pragma unroll
      for (int i = 0; i < 32; ++i) v[i] = __builtin_nontemporal_load(src + (size_t)i * ldw);
      u32x4* dst = reinterpret_cast<u32x4*>(Wt + (size_t)(drow0 + n) * 2048 + k0);
#pragma unroll
      for (int i = 0; i < 4; ++i) {
        u32x4 o = {pack2(v[8 * i], v[8 * i + 1]), pack2(v[8 * i + 2], v[8 * i + 3]), pack2(v[8 * i + 4], v[8 * i + 5]), pack2(v[8 * i + 6], v[8 * i + 7])};
        dst[i] = o;
      }
    }
  }
}

DI void norm_phase(const float* xp, const float* xs, const float* w, u16* h) {
  const int tid = opq(threadIdx.x); const int lane = tid & 63, wv = tid >> 6;
  for (int row = blockIdx.x * 8 + wv; row < MROWS; row += gridDim.x * 8) {
    const float* src = row < PROWS ? xp + (size_t)row * DM : xs + (size_t)(row - PROWS) * DM;
    float4 v[8]; float ss = 0.f;
#pragma unroll
    for (int i = 0; i < 8; ++i) { const f32x4 t4 = __builtin_nontemporal_load(reinterpret_cast<const f32x4*>(src) + i * 64 + lane); v[i] = make_float4(t4[0], t4[1], t4[2], t4[3]); ss += v[i].x * v[i].x + v[i].y * v[i].y + v[i].z * v[i].z + v[i].w * v[i].w; }
    ss = wave_sum(ss);
    const float r = rsqrtf(ss * (1.f / 2048.f) + 1e-6f);
    u32x2* dst = reinterpret_cast<u32x2*>(h + (size_t)row * DM);
#pragma unroll
    for (int i = 0; i < 8; ++i) {
      const float4 ww = reinterpret_cast<const float4*>(w)[i * 64 + lane];
      u32x2 o = {pack2(v[i].x * r * ww.x, v[i].y * r * ww.y), pack2(v[i].z * r * ww.z, v[i].w * r * ww.w)};
      dst[i * 64 + lane] = o;
    }
  }
}

DI void final_norm_phase(float* y, const float* w, const float* rs) {
  const int tid = opq(threadIdx.x); const int lane = tid & 63, wv = tid >> 6;
  for (int row = blockIdx.x * 8 + wv; row < MROWS; row += gridDim.x * 8) {
    float4* src = reinterpret_cast<float4*>(y + (size_t)row * DM);
    const float r = rsqrtf(rs[row] * (1.f / 2048.f) + 1e-6f);
#pragma unroll
    for (int i = 0; i < 8; ++i) {
      const float4 v = src[i * 64 + lane];
      const float4 ww = reinterpret_cast<const float4*>(w)[i * 64 + lane];
      f32x4 o = {v.x * r * ww.x, v.y * r * ww.y, v.z * r * ww.z, v.w * r * ww.w};
      __builtin_nontemporal_store(o, reinterpret_cast<f32x4*>(src) + i * 64 + lane);
    }
  }
}

namespace pg8 {
constexpr int BM = 256, BK = 64, HALF = 128, HTB = HALF * BK * 2, NXCD = 8, WGM = 8;
DI int lds_byte(int r, int c) { const int st = (r >> 4) * 2 + (c >> 5), rr = r & 15, cc = c & 31, ob = rr * 64 + cc * 2; return st * 1024 + (ob ^ (((ob >> 9) & 1) << 5)); }
DI void stage_rc(int b, int& R, int& C) { const int st = b / 1024, sb = b % 1024, swz = sb ^ (((sb >> 9) & 1) << 5); R = (st >> 1) * 16 + swz / 64; C = (st & 1) * 32 + (swz % 64) / 2; }
DI int perm32(int rho) { const int n = rho >> 4, i = rho & 15; return 8 * (i >> 2) + 4 * n + (i & 3); }
struct Unit { int pm, pn; };
struct Gemm { const u16* A; const u16* Bt; int M, N, K; };
struct StaticOrder {
  int nM, nN, nwg, G, c;
  DI void init(int M, int N, int G_, int c_) { nM = M / BM; nN = N / BM; nwg = nM * nN; G = G_; c = c_; }
  DI bool next(int i, Unit& u) const {
    const long L = (long)i * G + c; if (L >= nwg) return false;
    int wgid = (int)L; { const int q = nwg / NXCD, r = nwg % NXCD, xcd = wgid % NXCD, off = wgid / NXCD; wgid = (xcd < r ? xcd * (q + 1) : r * (q + 1) + (xcd - r) * q) + off; }
    const int nig = WGM * nN, gid = wgid / nig, fm = gid * WGM, gsz = (nM - fm) < WGM ? (nM - fm) : WGM;
    u.pm = fm + ((wgid % nig) % gsz); u.pn = (wgid % nig) / gsz; return true;
  }
};

template <class Epi>
DI void gemm_phase(LAS unsigned char* lds, const Gemm g, const StaticOrder& S, const Epi& E) {
  const int tid = opq(threadIdx.x), wid = __builtin_amdgcn_readfirstlane(tid >> 6), lane = tid & 63, wr = wid >> 2, wc = wid & 3, fr = lane & 15, fq = lane >> 4;
  const int K = g.K, nt = K / BK;
  unsigned voffA[2], voffB[2];
#pragma unroll
  for (int i = 0; i < 2; ++i) { int R, C; stage_rc(tid * 16 + i * 8192, R, C); const int Rb = Epi::PERM ? ((R & ~31) + perm32(R & 31)) : R;
    voffA[i] = (unsigned)(R * K + C) * 2u; voffB[i] = (unsigned)(Rb * K + C) * 2u; }
  const size_t kstep = (size_t)(BK * 2);
  const size_t hstep = (size_t)HALF * K * 2;
  const size_t tstep = 2 * hstep;
  const unsigned ldsw = (unsigned)wid * 1024u;
  const int aoff = lds_byte(wr * 64 + fr, fq * 8), boff = lds_byte(wc * 32 + fr, fq * 8);
#define PG8_SA(b, h) (((b) * 2 + (h)) * HTB)
#define PG8_SB(b, h) ((4 + (b) * 2 + (h)) * HTB)
#define PG8_STAGE(bufoff, gbase, voff) do { _Pragma("unroll") for (int _i = 0; _i < 2; ++_i) \
    __builtin_amdgcn_global_load_lds((const unsigned*)((const char*)(gbase) + (voff)[_i]), (LAS unsigned*)(lds + (bufoff) + ldsw + _i * 8192), 16, 0, 0); } while (0)
#define PG8_LDA(dst, b, h) do { _Pragma("unroll") for (int m = 0; m < 4; ++m) _Pragma("unroll") for (int k = 0; k < 2; ++k) dst[m][k] = *(const LAS bf16x8*)(lds + PG8_SA(b, h) + aoff + m * 2048 + k * 1024); } while (0)
#define PG8_LDB(dst, b, h) do { _Pragma("unroll") for (int n = 0; n < 2; ++n) _Pragma("unroll") for (int k = 0; k < 2; ++k) dst[n][k] = *(const LAS bf16x8*)(lds + PG8_SB(b, h) + boff + n * 2048 + k * 1024); } while (0)
#define PG8_MMA(ai, bj, At, Bt) do { __builtin_amdgcn_s_setprio(1); _Pragma("unroll") for (int m = 0; m < 4; ++m) _Pragma("unroll") for (int n = 0; n < 2; ++n) _Pragma("unroll") for (int k = 0; k < 2; ++k) \
    acc[ai][bj][m][n] = __builtin_amdgcn_mfma_f32_16x16x32_bf16(Bt[n][k], At[m][k], acc[ai][bj][m][n], 0, 0, 0); __builtin_amdgcn_s_setprio(0); } while (0)
#define PG8_WAIT_V(n) asm volatile("s_waitcnt vmcnt(" #n ")" ::: "memory")
#define PG8_WAIT_L(n) asm volatile("s_waitcnt lgkmcnt(" #n ")" ::: "memory")
#define PG8_BAR __builtin_amdgcn_s_barrier()
#define PG8_SCHED __builtin_amdgcn_sched_barrier(0)
  Unit cur, nxt; int ui = 0;
  if (!S.next(0, cur)) return;
  f32x4 acc[2][2][4][2];
#pragma unroll
  for (int a = 0; a < 2; ++a)
#pragma unroll
    for (int b = 0; b < 2; ++b)
#pragma unroll
      for (int m = 0; m < 4; ++m)
#pragma unroll
        for (int n = 0; n < 2; ++n) acc[a][b][m][n] = (f32x4){0.f, 0.f, 0.f, 0.f};
  bf16x8 At[4][2], B0[2][2], B1[2][2];
  const char* cA = (const char*)g.A + (size_t)cur.pm * tstep; const char* cB = (const char*)g.Bt + (size_t)cur.pn * tstep;
  PG8_STAGE(PG8_SB(0, 0), cB, voffB); PG8_STAGE(PG8_SA(0, 0), cA, voffA); PG8_STAGE(PG8_SB(0, 1), cB + hstep, voffB); PG8_STAGE(PG8_SA(0, 1), cA + hstep, voffA);
  if (wr == 1) PG8_BAR;
  PG8_WAIT_V(4); PG8_BAR;
  PG8_STAGE(PG8_SB(1, 0), cB + kstep, voffB); PG8_STAGE(PG8_SA(1, 0), cA + kstep, voffA); PG8_STAGE(PG8_SB(1, 1), cB + hstep + kstep, voffB);
  PG8_WAIT_V(6); PG8_BAR;
  for (;;) {
    const bool has_next = S.next(ui + 1, nxt);
    const char* nA = has_next ? (const char*)g.A + (size_t)nxt.pm * tstep : cA; const char* nB = has_next ? (const char*)g.Bt + (size_t)nxt.pn * tstep : cB;
    for (int t = 0; t < nt; t += 2) {
      const bool last = (t == nt - 2);
      const char* a1 = cA + (size_t)(t + 1) * kstep;
      const char* a2 = last ? nA : cA + (size_t)(t + 2) * kstep; const char* b2 = last ? nB : cB + (size_t)(t + 2) * kstep;
      const char* a3 = a2 + kstep; const char* b3 = b2 + kstep;
      PG8_LDB(B0, 0, 0); PG8_SCHED; PG8_LDA(At, 0, 0); PG8_STAGE(PG8_SA(1, 1), a1 + hstep, voffA);
      PG8_WAIT_L(8); PG8_BAR; PG8_WAIT_L(0); PG8_MMA(0, 0, At, B0); PG8_BAR; PG8_SCHED;
      PG8_LDB(B1, 0, 1); PG8_STAGE(PG8_SB(0, 0), b2, voffB);
      PG8_BAR; PG8_WAIT_L(0); PG8_MMA(0, 1, At, B1); PG8_BAR;
      PG8_LDA(At, 0, 1); PG8_STAGE(PG8_SA(0, 0), a2, voffA);
      PG8_BAR; PG8_WAIT_L(0); PG8_MMA(1, 0, At, B0); PG8_BAR; PG8_SCHED;
      PG8_STAGE(PG8_SB(0, 1), b2 + hstep, voffB);
      PG8_WAIT_V(6); PG8_BAR; PG8_MMA(1, 1, At, B1); PG8_BAR;
      PG8_LDB(B0, 1, 0); PG8_SCHED; PG8_LDA(At, 1, 0); PG8_STAGE(PG8_SA(0, 1), a2 + hstep, voffA);
      PG8_WAIT_L(8); PG8_BAR; PG8_WAIT_L(0); PG8_MMA(0, 0, At, B0); PG8_BAR; PG8_SCHED;
      PG8_LDB(B1, 1, 1); PG8_STAGE(PG8_SB(1, 0), b3, voffB);
      PG8_BAR; PG8_WAIT_L(0); PG8_MMA(0, 1, At, B1); PG8_BAR;
      PG8_LDA(At, 1, 1); PG8_STAGE(PG8_SA(1, 0), a3, voffA);
      PG8_BAR; PG8_WAIT_L(0); PG8_MMA(1, 0, At, B0); PG8_BAR; PG8_SCHED;
      PG8_STAGE(PG8_SB(1, 1), b3 + hstep, voffB);
      PG8_WAIT_V(6); PG8_BAR; PG8_MMA(1, 1, At, B1); PG8_BAR;
    }
    E(acc, cur, wr, wc, fr, fq);
    if (!has_next) break;
#pragma unroll
    for (int a = 0; a < 2; ++a)
#pragma unroll
      for (int b = 0; b < 2; ++b)
#pragma unroll
        for (int m = 0; m < 4; ++m)
#pragma unroll
          for (int n = 0; n < 2; ++n) acc[a][b][m][n] = (f32x4){0.f, 0.f, 0.f, 0.f};
    cur = nxt; cA = nA; cB = nB; ++ui;
  }
  PG8_WAIT_V(0);
  if (wr == 0) PG8_BAR;
  PG8_BAR;
#undef PG8_SA
#undef PG8_SB
#undef PG8_STAGE
#undef PG8_LDA
#undef PG8_LDB
#undef PG8_MMA
#undef PG8_WAIT_V
#undef PG8_WAIT_L
#undef PG8_BAR
#undef PG8_SCHED
}

struct EpiProj {
  static constexpr bool PERM = true;
  u16* O; int ldc; float* out; int mode; const float* rs;
  DI void operator()(const f32x4 (&acc)[2][2][4][2], const Unit& u, int wr, int wc, int fr, int fq) const {
    const int row0 = u.pm * BM + wr * 64 + fr, colt = u.pn * BM, col0 = colt + wc * 32 + 8 * fq;
    const bool kv = (mode == 1) && colt >= 2048 && colt < 6144;
    const int sec = colt >= 4096 ? 1 : 0;
#pragma unroll
    for (int ai = 0; ai < 2; ++ai)
#pragma unroll
      for (int m = 0; m < 4; ++m) {
        const int row = row0 + ai * HALF + m * 16;
        u16* rowp = O + (size_t)row * ldc + col0;
        const float rr = rs ? rsqrtf(rs[row] * (1.f / 2048.f) + 1e-6f) : 1.f;
#pragma unroll
        for (int bj = 0; bj < 2; ++bj) {
          const f32x4 v0 = acc[ai][bj][m][0] * rr, v1 = acc[ai][bj][m][1] * rr;
          u32x4 w = {pack2(v0[0], v0[1]), pack2(v0[2], v0[3]), pack2(v1[0], v1[1]), pack2(v1[2], v1[3])};
          *reinterpret_cast<u32x4*>(rowp + bj * HALF) = w;
          if (kv) {
            const int c2 = col0 + bj * HALF - 2048 - sec * 2048;
            float* dst = row < PROWS ? out + (sec ? OFF_VP : OFF_KP) + (size_t)row * DM + c2 : out + (sec ? OFF_VS : OFF_KS) + (size_t)(row - PROWS) * DM + c2;
            __builtin_nontemporal_store(v0, reinterpret_cast<f32x4*>(dst)); __builtin_nontemporal_store(v1, reinterpret_cast<f32x4*>(dst + 4));
          }
        }
      }
  }
};
struct EpiRes {
  static constexpr bool PERM = true;
  const float* xp; const float* xs; float* out; int layer; const float* wn; u16* xw; float* rs;
  DI void operator()(const f32x4 (&acc)[2][2][4][2], const Unit& u, int wr, int wc, int fr, int fq) const {
    const int row0 = u.pm * BM + wr * 64 + fr, col0 = u.pn * BM + wc * 32 + 8 * fq;
    f32x4 wv[2][2];
#pragma unroll
    for (int bj = 0; bj < 2; ++bj)
#pragma unroll
      for (int n = 0; n < 2; ++n) wv[bj][n] = xw ? *reinterpret_cast<const f32x4*>(wn + col0 + bj * HALF + n * 4) : (f32x4){0.f, 0.f, 0.f, 0.f};
#pragma unroll
    for (int ai = 0; ai < 2; ++ai)
#pragma unroll
      for (int m = 0; m < 4; ++m) {
        const int row = row0 + ai * HALF + m * 16;
        float* dst = out + (size_t)row * DM + col0;
        const float* src = layer == 0 ? (row < PROWS ? xp + (size_t)row * DM + col0 : xs + (size_t)(row - PROWS) * DM + col0) : dst;
        float ss = 0.f;
#pragma unroll
        for (int bj = 0; bj < 2; ++bj) {
          const f32x4 x0 = *reinterpret_cast<const f32x4*>(src + bj * HALF), x1 = *reinterpret_cast<const f32x4*>(src + bj * HALF + 4);
          const f32x4 n0 = x0 + acc[ai][bj][m][0], n1 = x1 + acc[ai][bj][m][1];
          *reinterpret_cast<f32x4*>(dst + bj * HALF) = n0; *reinterpret_cast<f32x4*>(dst + bj * HALF + 4) = n1;
          ss += n0[0] * n0[0] + n0[1] * n0[1] + n0[2] * n0[2] + n0[3] * n0[3] + n1[0] * n1[0] + n1[1] * n1[1] + n1[2] * n1[2] + n1[3] * n1[3];
          if (xw) {
            const f32x4 h0 = n0 * wv[bj][0], h1 = n1 * wv[bj][1];
            u32x4 pk = {pack2(h0[0], h0[1]), pack2(h0[2], h0[3]), pack2(h1[0], h1[1]), pack2(h1[2], h1[3])};
            *reinterpret_cast<u32x4*>(xw + (size_t)row * DM + col0 + bj * HALF) = pk;
          }
        }
        ss += __shfl_xor(ss, 16); ss += __shfl_xor(ss, 32);
        if (fq == 0) atomicAdd(rs + row, ss);
      }
  }
};
}

template <class Epi>
DI void gemm8(char* smem, const u16* A, const u16* Bt, int N, const Epi& E) {
  pg8::Gemm g; g.A = A; g.Bt = Bt; g.M = MROWS; g.N = N; g.K = 2048;
  pg8::StaticOrder S; S.init(MROWS, N, gridDim.x, blockIdx.x);
  pg8::gemm_phase<Epi>((LAS unsigned char*)smem, g, S, E);
}

template <int KIND> struct RC {
  static constexpr int H = KIND == 0 ? 4 : 16;
  static constexpr int KH = KIND == 0 ? 256 : 128;
  static constexpr int VH = KIND == 0 ? 512 : 128;
  static constexpr int HPB = 256 / KH;
  static constexpr int LD = KIND == 0 ? GLA_LD : 8192;
  static constexpr int NIT = 264 * H;
  static constexpr int VOFF = KIND == 0 ? 2048 : 4096;
  static constexpr size_t SZQ = (size_t)NIT * 64 * KH;
  static constexpr size_t SZV = (size_t)NIT * VH * 64;
};

template <int KIND>
DI void prep_phase(const Params& p, int layer, int j, const u16* proj, char* prep, char* smem) {
  using C = RC<KIND>;
  constexpr int H = C::H, KH = C::KH, VH = C::VH, HPB = C::HPB, LD = C::LD, KTH = KH / 32;
  constexpr float L2E = 1.4426950408889634f, LN2 = 0.6931471805599453f;
  u16* QF = reinterpret_cast<u16*>(prep);
  u16* KF = QF + C::SZQ;
  u16* VF = KF + C::SZQ;
  u16* AF = VF + C::SZV;
  float* DL = reinterpret_cast<float*>(AF + (size_t)C::NIT * 4096);
  const int tid = opq(threadIdx.x), half = tid >> 8, c = tid & 255, lane = tid & 63, wvl = (tid >> 6) & 3, l31 = lane & 31, hh = lane >> 5;
  u16* qs = reinterpret_cast<u16*>(smem) + half * (2 * 64 * 264 + 64 * 16);
  u16* ks = qs + 64 * 264;
  u16* as = ks + 64 * 264;
  constexpr int HG = H / HPB;
  const int nblk = 264 * HG;
  for (int bi = blockIdx.x * 2 + half; bi < nblk; bi += gridDim.x * 2) {
    const int cgk = bi / HG, hg = bi - cgk * HG;
    const int nvalid = cgk < 256 ? 64 : 32;
    const size_t row0 = cgk < 256 ? (size_t)cgk * 64 : (size_t)PROWS + (size_t)(cgk - 256) * 32;
    const int head = hg * HPB + c / KH, kk = c % KH;
    const int item = cgk * H + head;
    float w2[16]; float ba = 0.f, lb = 0.f;
    if (KIND == 0) {
#pragma unroll
      for (int r = 0; r < 16; ++r) w2[r] = p.gla_w_a2[(size_t)j * 16 * 1024 + r * 1024 + head * 256 + kk];
      ba = p.gla_b_a[j * 1024 + head * 256 + kk];
    } else {
#pragma unroll
      for (int r = 0; r < 16; ++r) w2[r] = 0.f;
      const int ch = head * 128 + kk;
      float l0 = p.hgrn_lb[ch], l1 = p.hgrn_lb[2048 + ch], l2 = p.hgrn_lb[4096 + ch], l3 = p.hgrn_lb[6144 + ch];
      float mx = fmaxf(fmaxf(l0, l1), fmaxf(l2, l3));
      float e0 = expf(l0 - mx), e1 = expf(l1 - mx), e2 = expf(l2 - mx), e3 = expf(l3 - mx);
      float inv = 1.f / (e0 + e1 + e2 + e3);
      float acc = 0.f;
      if (layer >= 1) acc += e1;
      if (layer >= 2) acc += e2;
      if (layer >= 3) acc += e3;
      lb = acc * inv;
    }
    __syncthreads();
    {
      const u16* qsrc = proj + row0 * LD + hg * 256;
      const u16* ksrc = qsrc + (KIND == 0 ? 1024 : 2048);
#pragma unroll
      for (int i = 0; i < 8; ++i) {
        const int id = c + 256 * i, t = id >> 5, ch = id & 31;
        u32x4 vq = {0u, 0u, 0u, 0u}, vk = {0u, 0u, 0u, 0u};
        if (t < nvalid) {
          vq = __builtin_nontemporal_load(reinterpret_cast<const u32x4*>(qsrc + (size_t)t * LD + ch * 8));
          vk = __builtin_nontemporal_load(reinterpret_cast<const u32x4*>(ksrc + (size_t)t * LD + ch * 8));
        }
        *reinterpret_cast<u32x4*>(qs + t * 264 + ch * 8) = vq;
        *reinterpret_cast<u32x4*>(ks + t * 264 + ch * 8) = vk;
      }
      if (KIND == 0 && c < 128) {
        const int t = c >> 1, part = c & 1;
        u32x4 va = {0u, 0u, 0u, 0u};
        if (t < nvalid) va = *reinterpret_cast<const u32x4*>(proj + (row0 + t) * LD + 6144 + part * 8);
        *reinterpret_cast<u32x4*>(as + t * 16 + part * 8) = va;
      }
    }
    __syncthreads();
    float b = 0.f;
    {
      const int kt = kk >> 5, kl = kk & 31;
      u16* kfb = KF + (size_t)item * 64 * KH + ((size_t)(kt * 4) * 64 + kl) * 8;
#pragma unroll 2
      for (int t8 = 0; t8 < 8; ++t8) {
        u32 pk[4];
#pragma unroll
        for (int e = 0; e < 4; ++e) {
          u16 kb[2];
#pragma unroll
          for (int q = 0; q < 2; ++q) {
            const int t = t8 * 8 + 2 * e + q;
            const float qr = bf2f(qs[t * 264 + c]), kr = bf2f(ks[t * 264 + c]);
            float qv, kv, g;
            if (KIND == 0) {
              qv = qr * 0.0625f; kv = kr;
              const u32x4 a0 = *reinterpret_cast<const u32x4*>(as + t * 16);
              const u32x4 a1 = *reinterpret_cast<const u32x4*>(as + t * 16 + 8);
              float x = ba;
              x += bflo(a0.x) * w2[0] + bfhi(a0.x) * w2[1] + bflo(a0.y) * w2[2] + bfhi(a0.y) * w2[3];
              x += bflo(a0.z) * w2[4] + bfhi(a0.z) * w2[5] + bflo(a0.w) * w2[6] + bfhi(a0.w) * w2[7];
              x += bflo(a1.x) * w2[8] + bfhi(a1.x) * w2[9] + bflo(a1.y) * w2[10] + bfhi(a1.y) * w2[11];
              x += bflo(a1.z) * w2[12] + bfhi(a1.z) * w2[13] + bflo(a1.w) * w2[14] + bfhi(a1.w) * w2[15];
              const float ex = __builtin_amdgcn_exp2f(-fabsf(x) * L2E);
              g = (fminf(x, 0.f) - __builtin_amdgcn_logf(1.f + ex) * LN2) * 0.0625f;
            } else {
              qv = qr / (1.f + __builtin_amdgcn_exp2f(-qr * L2E)) * 0.08838834764831845f;
              const float sg = 1.f / (1.f + __builtin_amdgcn_exp2f(-kr * L2E));
              const float fg = lb + (1.f - lb) * sg;
              kv = 1.f - fg;
              g = __builtin_amdgcn_logf(fg) * LN2;
            }
            if (t >= nvalid) { qv = 0.f; kv = 0.f; g = 0.f; }
            b += g;
            qs[t * 264 + c] = f2bf(qv * __builtin_amdgcn_exp2f(b * L2E));
            kb[q] = f2bf(kv * __builtin_amdgcn_exp2f(fminf(-b, 80.f) * L2E));
            ks[t * 264 + c] = kb[q];
          }
          pk[e] = (u32)kb[0] | ((u32)kb[1] << 16);
        }
        u32x4 o = {pk[0], pk[1], pk[2], pk[3]};
        *reinterpret_cast<u32x4*>(kfb + ((size_t)((t8 >> 1) * 64 + (t8 & 1) * 32)) * 8) = o;
      }
    }
    DL[(size_t)item * KH + kk] = __builtin_amdgcn_exp2f(b * L2E);
    __syncthreads();
    for (int jb = wvl; jb < HPB * 4; jb += 4) {
      const int hl = jb >> 2, tr = (jb >> 1) & 1, tc = jb & 1;
      f32x16 acc = zero16();
      if (!(tr == 0 && tc == 1)) {
#pragma unroll
        for (int s = 0; s < KH / 16; ++s) {
          bf16x8 a = ld16(qs + (tr * 32 + l31) * 264 + hl * KH + s * 16 + hh * 8);
          bf16x8 bb = ld16(ks + (tc * 32 + l31) * 264 + hl * KH + s * 16 + hh * 8);
          acc = MFMA(a, bb, acc);
        }
      }
      u16* am = AF + (size_t)(cgk * H + hg * HPB + hl) * 4096;
      const int scol = tc * 32 + l31;
      const int s16 = scol >> 4, hs = (scol >> 3) & 1, jj = scol & 7;
#pragma unroll
      for (int reg = 0; reg < 16; ++reg) {
        const int tl = crow(reg, hh), t = tr * 32 + tl;
        am[((tr * 4 + s16) * 64 + hs * 32 + tl) * 8 + jj] = f2bf(scol <= t ? acc[reg] : 0.f);
      }
    }
#pragma unroll
    for (int i = 0; i < 8; ++i) {
      const int f = c + 256 * i, fl = f & 63, fi = f >> 6;
      const int mt = fi & 1, s = (fi >> 1) & 1, ktg = fi >> 2;
      const int hl = ktg / KTH, kt = ktg % KTH;
      const int t = mt * 32 + (fl & 31), fh = fl >> 5;
      const u16* src = qs + t * 264 + ktg * 32 + 16 * s + 4 * fh;
      const bf16x8 v = ld8x2(src, src + 8);
      *reinterpret_cast<bf16x8*>(QF + (size_t)(cgk * H + hg * HPB + hl) * 64 * KH + ((size_t)(((kt * 2 + s) * 2 + mt) * 64 + fl)) * 8) = v;
    }
#pragma unroll 1
    for (int pc = 0; pc < HPB * VH / 256; ++pc) {
      __syncthreads();
      {
        const u16* vsrc = proj + row0 * LD + C::VOFF + (hg * HPB) * VH + pc * 256;
#pragma unroll
        for (int i = 0; i < 8; ++i) {
          const int id = c + 256 * i, t = id >> 5, ch = id & 31;
          u32x4 vv = {0u, 0u, 0u, 0u};
          if (t < nvalid) vv = __builtin_nontemporal_load(reinterpret_cast<const u32x4*>(vsrc + (size_t)t * LD + ch * 8));
          *reinterpret_cast<u32x4*>(qs + t * 264 + ch * 8) = vv;
        }
      }
      __syncthreads();
      const int cv = pc * 256 + c;
      const int hl = cv / VH, v = cv % VH;
      u16* dst = VF + (size_t)(cgk * H + hg * HPB + hl) * VH * 64 + ((size_t)((v >> 5) * 4) * 64 + (v & 31)) * 8;
#pragma unroll
      for (int t8 = 0; t8 < 8; ++t8) {
        u32 pk[4];
#pragma unroll
        for (int e = 0; e < 4; ++e) {
          const int t = t8 * 8 + 2 * e;
          pk[e] = (u32)qs[t * 264 + c] | ((u32)qs[(t + 1) * 264 + c] << 16);
        }
        u32x4 o = {pk[0], pk[1], pk[2], pk[3]};
        *reinterpret_cast<u32x4*>(dst + ((size_t)((t8 >> 1) * 64 + (t8 & 1) * 32)) * 8) = o;
      }
    }
  }
}

template <int NA_> struct SeqOps { bf16x8 q[2][2]; bf16x8 k[4]; bf16x8 v[4]; bf16x8 a[NA_]; float4 dl[4]; };

template <int KIND>
DI void seq_phase(const Params& p, int j, const char* prep, u16* obuf, char* smem) {
  using C = RC<KIND>;
  constexpr int H = C::H, KH = C::KH, VH = C::VH, WPI = KH / 32, IPB = 8 / WPI, NA = 8 / WPI, NVS = VH / 32, NV = 32 / WPI;
  const u16* QF = reinterpret_cast<const u16*>(prep);
  const u16* KF = QF + C::SZQ;
  const u16* VF = KF + C::SZQ;
  const u16* AF = VF + C::SZV;
  const float* DL = reinterpret_cast<const float*>(AF + (size_t)C::NIT * 4096);
  float* red = reinterpret_cast<float*>(smem);
  const int tid = opq(threadIdx.x), lane = tid & 63, wv = __builtin_amdgcn_readfirstlane(tid >> 6), l31 = lane & 31, hh = lane >> 5;
  const int grp = wv / WPI, wg = wv % WPI, kt = wg;
  constexpr int nitems = 12 * H * NVS, nbitems = nitems / IPB;
  constexpr size_t SSZ = (size_t)H * KH * VH;
  int cnt = 0;
  for (int bitem = blockIdx.x; bitem < nbitems; bitem += gridDim.x) {
    int bsel = bitem;
    {
      constexpr int PER_BH = NVS / IPB, NBH = 4 * H, NPB = NBH * PER_BH;
      if (bitem < NPB) { const int x = bitem & 7, i = bitem >> 3; bsel = (x * (NBH / 8) + i / PER_BH) * PER_BH + i % PER_BH; }
    }
    const int it = bsel * IPB + grp;
    const int seq = it / (H * NVS), rem = it % (H * NVS), head = rem / NVS, vs = rem % NVS;
    const size_t sbase = (size_t)head * KH * VH + (size_t)(kt * 32) * VH + vs * 32 + l31;
    float* st_out;
    if (KIND == 0) st_out = seq < 4 ? p.out + OFF_GSP + (size_t)(j * 4 + seq) * SSZ : p.out + OFF_GSS + (size_t)(j * 8 + seq - 4) * SSZ;
    else st_out = seq < 4 ? p.out + OFF_HSP + (size_t)seq * SSZ : p.out + OFF_HSS + (size_t)(seq - 4) * SSZ;
    f32x16 S;
    if (seq >= 4) {
      const float* st_in = (KIND == 0 ? p.state_gla + (size_t)j * 8 * SSZ : p.state_hgrn) + (size_t)(seq - 4) * SSZ;
#pragma unroll
      for (int reg = 0; reg < 16; ++reg) S[reg] = st_in[sbase + (size_t)crow(reg, hh) * VH];
    } else {
      S = zero16();
    }
    const int nch = seq < 4 ? 64 : 1;
    const int cg0 = seq < 4 ? seq * 64 : 256 + seq - 4;
    const int nvalid = seq < 4 ? 64 : 32;
    SeqOps<NA> cur, nxt;
    auto load_ops = [&](SeqOps<NA>& o, int cgk) {
      const size_t item = (size_t)cgk * H + head;
      const u16* qb = QF + item * 64 * KH + (size_t)(kt * 4) * 512 + lane * 8;
#pragma unroll
      for (int s = 0; s < 2; ++s)
#pragma unroll
        for (int mt = 0; mt < 2; ++mt) o.q[s][mt] = ld16(qb + (s * 2 + mt) * 512);
      const u16* kb = KF + item * 64 * KH + (size_t)(kt * 4) * 512 + lane * 8;
#pragma unroll
      for (int s16 = 0; s16 < 4; ++s16) o.k[s16] = ld16(kb + s16 * 512);
      const u16* vb = VF + item * VH * 64 + (size_t)(vs * 4) * 512 + lane * 8;
#pragma unroll
      for (int s16 = 0; s16 < 4; ++s16) o.v[s16] = ld16(vb + s16 * 512);
#pragma unroll
      for (int i = 0; i < NA; ++i) o.a[i] = ld16(AF + item * 4096 + (size_t)(wg * NA + i) * 512 + lane * 8);
      const float* db = DL + item * KH + kt * 32 + 4 * hh;
#pragma unroll
      for (int g4 = 0; g4 < 4; ++g4) o.dl[g4] = *reinterpret_cast<const float4*>(db + 8 * g4);
    };
    load_ops(cur, cg0);
    constexpr bool DEFER = true;
    u32 osum[NV / 2];
    auto store_o = [&](size_t prow0) {
#pragma unroll
      for (int i = 0; i < NV; ++i) {
        const int vec = wg * NV + i;
        const int t = (vec >> 4) * 32 + crow(vec & 15, hh);
        if (t < nvalid) obuf[(prow0 + t) * DM + head * VH + vs * 32 + l31] = (u16)((i & 1) ? (osum[i >> 1] >> 16) : (osum[i >> 1] & 0xffffu));
      }
    };
    for (int ch = 0; ch < nch; ++ch) {
      if (DEFER && ch > 0) store_o((size_t)(cg0 + ch - 1) * 64);
      if (ch + 1 < nch) load_ops(nxt, cg0 + ch + 1);
      const size_t row0 = seq < 4 ? (size_t)(cg0 + ch) * 64 : (size_t)PROWS + (size_t)(seq - 4) * 32;
      f32x16 O[2]; O[0] = zero16(); O[1] = zero16();
      {
        const bf16x8 b0 = packacc<0>(S), b1 = packacc<1>(S);
        O[0] = MFMA(cur.q[0][0], b0, O[0]);
        O[1] = MFMA(cur.q[0][1], b0, O[1]);
        O[0] = MFMA(cur.q[1][0], b1, O[0]);
        O[1] = MFMA(cur.q[1][1], b1, O[1]);
      }
#pragma unroll
      for (int i = 0; i < NA; ++i) {
        const int pi = wg * NA + i;
#pragma unroll
        for (int mc = 0; mc < 2; ++mc)
#pragma unroll
          for (int sc = 0; sc < 4; ++sc)
            if (pi == mc * 4 + sc) O[mc] = MFMA(cur.a[i], cur.v[sc], O[mc]);
      }
      u32* rp = reinterpret_cast<u32*>(red) + ((size_t)((cnt & 1) * 8 + wv) * 16) * 64 + lane;
#pragma unroll
      for (int mt = 0; mt < 2; ++mt)
#pragma unroll
        for (int r2 = 0; r2 < 8; ++r2) rp[(mt * 8 + r2) * 64] = pack2(O[mt][2 * r2], O[mt][2 * r2 + 1]);
#pragma unroll
      for (int s16 = 0; s16 < 4; ++s16) S = MFMA(cur.k[s16], cur.v[s16], S);
#pragma unroll
      for (int g4 = 0; g4 < 4; ++g4) {
        S[4 * g4 + 0] *= cur.dl[g4].x; S[4 * g4 + 1] *= cur.dl[g4].y; S[4 * g4 + 2] *= cur.dl[g4].z; S[4 * g4 + 3] *= cur.dl[g4].w;
      }
      asm volatile("s_waitcnt lgkmcnt(0)" ::: "memory");
      __builtin_amdgcn_s_barrier();
      asm volatile("" ::: "memory");
      {
        const u32* rg = reinterpret_cast<const u32*>(red) + ((size_t)((cnt & 1) * 8 + grp * WPI) * 16) * 64 + lane;
#pragma unroll
        for (int i = 0; i < NV; i += 2) {
          float sum0 = 0.f, sum1 = 0.f;
#pragma unroll
          for (int w2 = 0; w2 < WPI; ++w2) { const u32 pk = rg[((size_t)w2 * 16 + (wg * NV + i) / 2) * 64]; sum0 += bflo(pk); sum1 += bfhi(pk); }
          osum[i >> 1] = pack2(sum0, sum1);
        }
        if (!DEFER) store_o(row0);
      }
      ++cnt;
      if (ch + 1 < nch) cur = nxt;
    }
    if (DEFER) store_o(seq < 4 ? (size_t)(cg0 + nch - 1) * 64 : (size_t)PROWS + (size_t)(seq - 4) * 32);
#pragma unroll
    for (int reg = 0; reg < 16; ++reg) __builtin_nontemporal_store(S[reg], st_out + sbase + (size_t)crow(reg, hh) * VH);
  }
}

DI void gate_phase(u16* hb, const u16* proj, int ld, int zoff, const float* w, int G, float scale) {
  const int tid = opq(threadIdx.x); const int lane = tid & 63, wv = tid >> 6;
  for (int row = blockIdx.x * 8 + wv; row < MROWS; row += gridDim.x * 8) {
    u32x2* hp = reinterpret_cast<u32x2*>(hb + (size_t)row * DM);
    const u32x2* zp = reinterpret_cast<const u32x2*>(proj + (size_t)row * ld + zoff);
    float o[8][4], ss[8];
#pragma unroll
    for (int i = 0; i < 8; ++i) {
      const u32x2 pk = __builtin_nontemporal_load(hp + i * 64 + lane);
      o[i][0] = bflo(pk.x); o[i][1] = bfhi(pk.x); o[i][2] = bflo(pk.y); o[i][3] = bfhi(pk.y);
      ss[i] = o[i][0] * o[i][0] + o[i][1] * o[i][1] + o[i][2] * o[i][2] + o[i][3] * o[i][3];
    }
#pragma unroll
    for (int i = 0; i < 8; ++i) ss[i] = wave_sum(ss[i]);
    if (G == 512) {
#pragma unroll
      for (int i = 0; i < 8; i += 2) { const float t = ss[i] + ss[i + 1]; ss[i] = t; ss[i + 1] = t; }
    } else if (G == 2048) {
      float t = 0.f;
#pragma unroll
      for (int i = 0; i < 8; ++i) t += ss[i];
#pragma unroll
      for (int i = 0; i < 8; ++i) ss[i] = t;
    }
    const float invG = 1.f / (float)G;
#pragma unroll
    for (int i = 0; i < 8; ++i) {
      const float r = rsqrtf(ss[i] * invG + 1e-6f) * scale;
      const int col = i * 256 + lane * 4;
      const float4 ww = *reinterpret_cast<const float4*>(w + (col & (G - 1)));
      const u32x2 zk = __builtin_nontemporal_load(zp + i * 64 + lane);
      const float z0 = bflo(zk.x), z1 = bfhi(zk.x), z2 = bflo(zk.y), z3 = bfhi(zk.y);
      const float g0 = o[i][0] * r * ww.x * (z0 / (1.f + expf(-z0)));
      const float g1 = o[i][1] * r * ww.y * (z1 / (1.f + expf(-z1)));
      const float g2 = o[i][2] * r * ww.z * (z2 / (1.f + expf(-z2)));
      const float g3 = o[i][3] * r * ww.w * (z3 / (1.f + expf(-z3)));
      u32x2 ov = {pack2(g0, g1), pack2(g2, g3)};
      hp[i * 64 + lane] = ov;
    }
  }
}

constexpr size_t SZ_VTP = (size_t)4 * 8 * 256 * 4096;
constexpr size_t SZ_KS = (size_t)8 * 16 * 1088 * 128;
DI void diffprep_cache(const Params& p, char* prep, int rank, int nranks) {
  u16* VTP = reinterpret_cast<u16*>(prep);
  u16* KS = VTP + SZ_VTP;
  u16* VTS = KS + SZ_KS;
  const int tid0 = opq(threadIdx.x), half = tid0 >> 8, tid = tid0 & 255;
  for (int it = rank * 2 + half; it < 8 * 8 * 16; it += nranks * 2) {
    const int kt = it & 15, bh = it >> 4, b = bh >> 3, h = bh & 7;
    u16* dst = VTS + ((size_t)((b * 8 + h) * 256 + tid)) * 1088 + kt * 64;
    const float* src = p.cache_v + ((size_t)(b * 1024 + kt * 64) * 8 + h) * 256 + tid;
#pragma unroll
    for (int g16 = 0; g16 < 4; ++g16) {
      float v[16];
#pragma unroll
      for (int e = 0; e < 16; ++e) v[e] = __builtin_nontemporal_load(src + (size_t)(g16 * 16 + e) * 2048);
      u32x4 o0 = {pack2(v[0], v[1]), pack2(v[2], v[3]), pack2(v[8], v[9]), pack2(v[10], v[11])};
      u32x4 o1 = {pack2(v[4], v[5]), pack2(v[6], v[7]), pack2(v[12], v[13]), pack2(v[14], v[15])};
      *reinterpret_cast<u32x4*>(dst + g16 * 16) = o0;
      *reinterpret_cast<u32x4*>(dst + g16 * 16 + 8) = o1;
    }
  }
  const int nchunks = 8 * 16 * 1024 * 16;
  for (int id = rank * 512 + tid0; id < nchunks; id += nranks * 512) {
    const int d8 = id & 15, rest = id >> 4, key = rest & 1023, bn = rest >> 10, b = bn >> 4, n = bn & 15;
    const float4* sp = reinterpret_cast<const float4*>(p.cache_k + ((size_t)(b * 1024 + key) * 16 + n) * 128 + d8 * 8);
    const f32x4 a = __builtin_nontemporal_load(reinterpret_cast<const f32x4*>(sp)), c = __builtin_nontemporal_load(reinterpret_cast<const f32x4*>(sp) + 1);
    u32x4 o = {pack2(a[0], a[1]), pack2(a[2], a[3]), pack2(c[0], c[1]), pack2(c[2], c[3])};
    *reinterpret_cast<u32x4*>(KS + ((size_t)(b * 16 + n) * 1088 + key) * 128 + d8 * 8) = o;
  }
}
DI void diffprep_phase(const Params& p, const u16* proj, char* prep, char* smem) {
  u16* VTP = reinterpret_cast<u16*>(prep);
  u16* KS = VTP + SZ_VTP;
  u16* VTS = KS + SZ_KS;
  const int tid0 = opq(threadIdx.x), half = tid0 >> 8, tid = tid0 & 255;
  u16* tl = reinterpret_cast<u16*>(smem) + half * (64 * 264);
  for (int it = blockIdx.x * 2 + half; it < 2048; it += gridDim.x * 2) {
    const int h = it & 7, c = (it >> 3) & 63, b = it >> 9;
    const u16* src = proj + (size_t)(b * 4096 + c * 64) * 8192 + 4096 + h * 256;
    __syncthreads();
#pragma unroll
    for (int i = 0; i < 8; ++i) {
      const int id = tid + 256 * i, t = id >> 5, ch = id & 31;
      *reinterpret_cast<u32x4*>(tl + t * 264 + ch * 8) = __builtin_nontemporal_load(reinterpret_cast<const u32x4*>(src + (size_t)t * 8192 + ch * 8));
    }
    __syncthreads();
    u16* dst = VTP + ((size_t)((b * 8 + h) * 256 + tid)) * 4096 + c * 64;
#pragma unroll
    for (int g16 = 0; g16 < 4; ++g16) {
      u32 pk[8];
#pragma unroll
      for (int e = 0; e < 8; ++e) {
        const int t = g16 * 16 + 2 * e;
        pk[e] = (u32)tl[t * 264 + tid] | ((u32)tl[(t + 1) * 264 + tid] << 16);
      }
      u32x4 o0 = {pk[0], pk[1], pk[4], pk[5]}, o1 = {pk[2], pk[3], pk[6], pk[7]};
      *reinterpret_cast<u32x4*>(dst + g16 * 16) = o0;
      *reinterpret_cast<u32x4*>(dst + g16 * 16 + 8) = o1;
    }
  }
  for (int it = blockIdx.x * 2 + half; it < 8 * 8; it += gridDim.x * 2) {
    const int b = it >> 3, h = it & 7;
    u16* dst = VTS + ((size_t)((b * 8 + h) * 256 + tid)) * 1088 + 16 * 64;
#pragma unroll
    for (int g16 = 0; g16 < 4; ++g16) {
      u32 pk[8];
#pragma unroll
      for (int e = 0; e < 8; ++e) {
        const int k0 = g16 * 16 + 2 * e;
        const u32 lo = k0 < 32 ? (u32)proj[(size_t)(PROWS + b * 32 + k0) * 8192 + 4096 + h * 256 + tid] : 0u;
        const u32 hi = k0 + 1 < 32 ? (u32)proj[(size_t)(PROWS + b * 32 + k0 + 1) * 8192 + 4096 + h * 256 + tid] : 0u;
        pk[e] = lo | (hi << 16);
      }
      u32x4 o0 = {pk[0], pk[1], pk[4], pk[5]}, o1 = {pk[2], pk[3], pk[6], pk[7]};
      *reinterpret_cast<u32x4*>(dst + g16 * 16) = o0;
      *reinterpret_cast<u32x4*>(dst + g16 * 16 + 8) = o1;
    }
  }
  const int nchunks = 8 * 16 * 64 * 16;
  for (int id = blockIdx.x * 512 + tid0; id < nchunks; id += gridDim.x * 512) {
    const int d8 = id & 15, rest = id >> 4, kl = rest & 63, bn = rest >> 6, b = bn >> 4, n = bn & 15;
    u32x4 o = {0u, 0u, 0u, 0u};
    if (kl < 32) o = *reinterpret_cast<const u32x4*>(proj + (size_t)(PROWS + b * 32 + kl) * 8192 + 2048 + n * 128 + d8 * 8);
    *reinterpret_cast<u32x4*>(KS + ((size_t)(b * 16 + n) * 1088 + 1024 + kl) * 128 + d8 * 8) = o;
  }
}

DI void attn_phase(const Params& p, const u16* proj, const char* prep, u16* obuf, char* smem) {
  const u16* VTP = reinterpret_cast<const u16*>(prep);
  const u16* KS = VTP + SZ_VTP;
  const u16* VTS = KS + SZ_KS;
  constexpr int BUFE = 2 * 64 * 136 + 256 * 72;
  u16* lds = reinterpret_cast<u16*>(smem);
  float* Ot = reinterpret_cast<float*>(smem);
  const int tid = opq(threadIdx.x), lane = tid & 63, wv = __builtin_amdgcn_readfirstlane(tid >> 6), l31 = lane & 31, hh = lane >> 5;
  const int qt = wv & 1, jh = (wv >> 1) & 1, vh = wv >> 2;
  const int G = gridDim.x;
  bool xcdmap = (G == 256);
  int xx = (int)blockIdx.x & 7, yy = (int)blockIdx.x >> 3;
  if (xcdmap) {
    const unsigned* bar = reinterpret_cast<const unsigned*>(p.ws + WS_BAR);
    bool even = true;
#pragma unroll
    for (int jx = 0; jx < 8; ++jx) even = even && (bar[256 + 64 * jx] == 32u);
    if (even) {
      const unsigned sl = reinterpret_cast<volatile unsigned*>(smem + LDS_BYTES - 16)[2];
      xx = (int)(sl >> 16) & 7; yy = (int)(sl & 31u);
    }
  }
  xx = __builtin_amdgcn_readfirstlane(xx); yy = __builtin_amdgcn_readfirstlane(yy);
  const int nrounds = xcdmap ? 9 : (2048 + 64 + G - 1) / G;
  for (int r = 0; r < nrounds; ++r) {
    int i;
    if (xcdmap) {
      const int x = xx, y = yy;
      if (r < 8) { const int bh = x * 4 + (r >> 1), c = (r & 1) ? y : 63 - y; i = ((63 - c) << 5) | bh; }
      else { i = (x * 32 + y) < 64 ? 2048 + (x * 32 + y) : 1 << 30; }
    } else {
      i = r * G + (int)blockIdx.x;
    }
    if (i >= 2048 + 64) continue;
    int b, h, nt, nkeys, nq; size_t qrow0, kstride, khs, vtstride; const u16* kbase; const u16* vtbase;
    if (i < 2048) {
      const int c = 63 - (i >> 5), bh = i & 31; b = bh >> 3; h = bh & 7; nt = c + 1; nkeys = nt * 64; nq = 64;
      qrow0 = (size_t)b * 4096 + c * 64;
      kbase = proj + (size_t)(b * 4096) * 8192 + 2048 + (2 * h) * 128; kstride = 8192; khs = 128;
      vtbase = VTP + (size_t)((b * 8 + h) * 256) * 4096; vtstride = 4096;
    } else {
      const int bh = i - 2048; b = bh >> 3; h = bh & 7; nt = 17; nkeys = 1056; nq = 32;
      qrow0 = (size_t)PROWS + b * 32;
      kbase = KS + (size_t)((b * 16 + 2 * h) * 1088) * 128; kstride = 128; khs = (size_t)1088 * 128;
      vtbase = VTS + (size_t)((b * 8 + h) * 256) * 1088; vtstride = 1088;
    }
    bf16x8 Qf[8];
    {
      const size_t qrow = qrow0 + ((qt * 32 < nq) ? qt * 32 : 0) + l31;
      const u16* qp = proj + qrow * 8192 + (2 * h + jh) * 128 + hh * 8;
#pragma unroll
      for (int s = 0; s < 8; ++s) Qf[s] = ld16(qp + s * 16);
#pragma unroll
      for (int s = 0; s < 8; ++s) asm volatile("" : "+v"(Qf[s]));
    }
    u32x4 kr[4], vr[4];
    auto gload = [&](int kt) {
#pragma unroll
      for (int ii = 0; ii < 4; ++ii) {
        const int id = tid + 512 * ii;
        const int jl = id >> 10, key = (id >> 4) & 63, ch = id & 15;
        kr[ii] = *reinterpret_cast<const u32x4*>(kbase + jl * khs + (size_t)(kt * 64 + key) * kstride + ch * 8);
        const int vd = id >> 3, cv = id & 7;
        vr[ii] = *reinterpret_cast<const u32x4*>(vtbase + (size_t)vd * vtstride + kt * 64 + cv * 8);
      }
    };
    auto sstore = [&](int buf) {
      u16* Ks = lds + buf * BUFE; u16* Vt = Ks + 2 * 64 * 136;
#pragma unroll
      for (int ii = 0; ii < 4; ++ii) {
        const int id = tid + 512 * ii;
        const int jl = id >> 10, key = (id >> 4) & 63, ch = id & 15;
        *reinterpret_cast<u32x4*>(Ks + (jl * 64 + key) * 136 + ch * 8) = kr[ii];
        const int vd = id >> 3, cv = id & 7;
        *reinterpret_cast<u32x4*>(Vt + vd * 72 + cv * 8) = vr[ii];
      }
    };
    float m = -1e30f, l = 0.f;
    f32x16 O[4];
#pragma unroll
    for (int vt = 0; vt < 4; ++vt) O[vt] = zero16();
#define ATT_BAR() do { asm volatile("s_waitcnt lgkmcnt(0)" ::: "memory"); __builtin_amdgcn_s_barrier(); asm volatile("" ::: "memory"); } while (0)
    const bool grpB = vh != 0;
    gload(0);
    __syncthreads();
    sstore(0);
    __syncthreads();
    if (nt > 1) gload(1);
    if (grpB) ATT_BAR();
    for (int kt = 0; kt < nt; ++kt) {
      const u16* Ks = lds + (kt & 1) * BUFE; const u16* Vt = Ks + 2 * 64 * 136;
      f32x16 st[2];
      __builtin_amdgcn_s_setprio(1);
#pragma unroll
      for (int kti = 0; kti < 2; ++kti) {
        st[kti] = zero16();
#pragma unroll
        for (int s = 0; s < 8; ++s) {
          const bf16x8 a = ld16(Ks + (jh * 64 + kti * 32 + l31) * 136 + s * 16 + hh * 8);
          st[kti] = MFMA(a, Qf[s], st[kti]);
        }
      }
      __builtin_amdgcn_s_setprio(0);
      constexpr float SC = 0.08838834764831845f * 1.4426950408889634f;
      if ((kt + 1) * 64 > nkeys) {
#pragma unroll
        for (int kti = 0; kti < 2; ++kti)
#pragma unroll
          for (int reg = 0; reg < 16; ++reg)
            if (kt * 64 + kti * 32 + crow(reg, hh) >= nkeys) st[kti][reg] = -1e30f;
      }
      float mx = -1e30f;
#pragma unroll
      for (int kti = 0; kti < 2; ++kti)
#pragma unroll
        for (int reg = 0; reg < 16; ++reg) mx = fmaxf(mx, st[kti][reg]);
      mx = fmaxf(mx, __shfl_xor(mx, 32)) * SC;
      const bool bump = __any(mx > m + 8.f);
      const float mn = bump ? fmaxf(m, mx) : m;
      float rs = 0.f;
#pragma unroll
      for (int kti = 0; kti < 2; ++kti)
#pragma unroll
        for (int reg = 0; reg < 16; ++reg) {
          const float pv = __builtin_amdgcn_exp2f(st[kti][reg] * SC - mn);
          st[kti][reg] = pv; rs += pv;
        }
      rs += __shfl_xor(rs, 32);
      if (bump) {
        const float alpha = __builtin_amdgcn_exp2f(m - mn);
        l *= alpha;
#pragma unroll
        for (int vt = 0; vt < 4; ++vt)
#pragma unroll
          for (int reg = 0; reg < 16; ++reg) O[vt][reg] *= alpha;
      }
      l += rs; m = mn;
      if (grpB && kt + 1 < nt) { sstore((kt + 1) & 1); if (kt + 2 < nt) gload(kt + 2); }
      ATT_BAR();
      __builtin_amdgcn_s_setprio(1);
#pragma unroll
      for (int kti = 0; kti < 2; ++kti) {
        {
          const bf16x8 pf = packacc<0>(st[kti]);
#pragma unroll
          for (int vt = 0; vt < 4; ++vt) {
            O[vt] = MFMA(ld16(Vt + ((vh * 4 + vt) * 32 + l31) * 72 + kti * 32 + 8 * hh), pf, O[vt]);
          }
        }
        {
          const bf16x8 pf = packacc<1>(st[kti]);
#pragma unroll
          for (int vt = 0; vt < 4; ++vt) {
            O[vt] = MFMA(ld16(Vt + ((vh * 4 + vt) * 32 + l31) * 72 + kti * 32 + 16 + 8 * hh), pf, O[vt]);
          }
        }
      }
      __builtin_amdgcn_s_setprio(0);
      if (!grpB && kt + 1 < nt) { sstore((kt + 1) & 1); if (kt + 2 < nt) gload(kt + 2); }
      ATT_BAR();
    }
    if (!grpB) ATT_BAR();
#undef ATT_BAR
    const float inv = 1.f / l;
    float lam;
    {
      const float* lp = p.diff_lambda;
      float s1 = lp[lane] * lp[128 + lane] + lp[64 + lane] * lp[192 + lane];
      float s2 = lp[256 + lane] * lp[384 + lane] + lp[320 + lane] * lp[448 + lane];
      s1 = wave_sum(s1); s2 = wave_sum(s2);
      lam = expf(s1) - expf(s2) + LAM_INIT;
    }
    if (jh == 1) {
#pragma unroll
      for (int vt = 0; vt < 4; ++vt)
#pragma unroll
        for (int reg = 0; reg < 16; ++reg) Ot[(qt * 32 + l31) * 257 + (vh * 4 + vt) * 32 + crow(reg, hh)] = lam * O[vt][reg] * inv;
    }
    __syncthreads();
    if (jh == 0) {
#pragma unroll
      for (int vt = 0; vt < 4; ++vt)
#pragma unroll
        for (int reg = 0; reg < 16; ++reg) {
          const int idx = (qt * 32 + l31) * 257 + (vh * 4 + vt) * 32 + crow(reg, hh);
          Ot[idx] = O[vt][reg] * inv - Ot[idx];
        }
    }
    __syncthreads();
    {
#pragma unroll 1
      for (int rr = 0; rr < 8; ++rr) {
        const int q = wv * 8 + rr;
        const float a0 = Ot[q * 257 + lane], a1 = Ot[q * 257 + 64 + lane], a2 = Ot[q * 257 + 128 + lane], a3 = Ot[q * 257 + 192 + lane];
        float ss = wave_sum(a0 * a0 + a1 * a1 + a2 * a2 + a3 * a3);
        if (lane == 0) Ot[q * 257 + 256] = rsqrtf(ss * (1.f / 256.f) + 1e-6f) * (1.f - LAM_INIT);
      }
    }
    __syncthreads();
    {
      u32 zk[16];
      const int te = opq(tid);
#pragma unroll
      for (int ii = 0; ii < 16; ++ii) {
        const int id = te + 512 * ii, q = id >> 7, vd = (id & 127) * 2;
        zk[ii] = __builtin_nontemporal_load(reinterpret_cast<const u32*>(proj + (qrow0 + (q < nq ? q : 0)) * 8192 + 6144 + h * 256 + vd));
      }
      const int vd0 = (te & 127) * 2;
      const float w0 = p.diff_subln_w[vd0], w1 = p.diff_subln_w[vd0 + 1];
#pragma unroll
      for (int ii = 0; ii < 16; ++ii) {
        const int id = te + 512 * ii, q = id >> 7, vd = (id & 127) * 2;
        if (q < nq) {
          const float r = Ot[q * 257 + 256];
          const float z0 = bflo(zk[ii]), z1 = bfhi(zk[ii]);
          const float g0 = Ot[q * 257 + vd] * r * w0 * (z0 / (1.f + __builtin_amdgcn_exp2f(-z0 * 1.4426950408889634f)));
          const float g1 = Ot[q * 257 + vd + 1] * r * w1 * (z1 / (1.f + __builtin_amdgcn_exp2f(-z1 * 1.4426950408889634f)));
          *reinterpret_cast<u32*>(obuf + (qrow0 + q) * DM + h * 256 + vd) = pack2(g0, g1);
        }
      }
    }
  }
}

#define XB_TMO      128
#define XB_XCNT(j)  (256  + 64 * (j))
#define XB_XSUB(j)  (1280 + 64 * (j))
#define XB_XGEN(j)  (2304 + 64 * (j))
#define XB_TOP      3328
#define XB_TOPGEN   3392
#define XCD_BAR_WORDS 3456
#define XB_SPIN_CAP (1u << 18)
DI unsigned xb_ld(unsigned* p) { return __hip_atomic_load(p, __ATOMIC_RELAXED, __HIP_MEMORY_SCOPE_AGENT); }
DI unsigned xb_add(unsigned* p, unsigned v) { return __hip_atomic_fetch_add(p, v, __ATOMIC_RELAXED, __HIP_MEMORY_SCOPE_AGENT); }
DI unsigned xb_xcc_id() { return (unsigned)__builtin_amdgcn_s_getreg((3 << 11) | 20) & 0xFu; }
#define XB_SPIN(cond, bar) do { unsigned _sp = 0; while (cond) { __builtin_amdgcn_s_sleep(1); \
    if ((++_sp & 255u) == 0u) { if (xb_ld(&(bar)[XB_TMO])) break; if (_sp > XB_SPIN_CAP) { atomicAdd(&(bar)[XB_TMO], 1u); break; } } } } while (0)
struct XcdBarrier { unsigned* bar; unsigned x; volatile LAS unsigned* st; };
DI XcdBarrier xcd_barrier_post(unsigned* bar, volatile LAS unsigned* st) {
  XcdBarrier b; b.bar = bar; b.x = xb_xcc_id(); b.st = st;
  if (threadIdx.x == 0) (void)xb_add(&bar[XB_XCNT(b.x)], 1u);
  return b;
}
DI void xcd_barrier_complete(unsigned* bar, unsigned x, unsigned& nloc, unsigned& nx) {
  const unsigned G = gridDim.x * gridDim.y * gridDim.z;
  unsigned sum, cnt, mine, sp = 0u;
  for (;;) {
    sum = 0u; cnt = 0u; mine = 0u;
#pragma unroll
    for (unsigned j = 0; j < 16; ++j) { const unsigned c = xb_ld(&bar[XB_XCNT(j)]); sum += c; cnt += (c > 0u) ? 1u : 0u; mine = (j == x) ? c : mine; }
    if (sum == G) break;
    __builtin_amdgcn_s_sleep(1);
    if ((++sp & 255u) == 0u) { if (xb_ld(&bar[XB_TMO])) break; if (sp > XB_SPIN_CAP) { atomicAdd(&bar[XB_TMO], 1u); break; } }
  }
  nloc = mine > 0u ? mine : 1u; nx = cnt > 0u ? cnt : 1u;
}
DI void xcd_barrier(const XcdBarrier& b) {
  asm volatile("s_waitcnt vmcnt(0)" ::: "memory");
  __syncthreads();
  if (threadIdx.x == 0) {
    unsigned* bar = b.bar;
    __builtin_amdgcn_s_waitcnt(0);
    unsigned nloc = b.st[0], nx = b.st[1];
    if (nloc == 0u) { xcd_barrier_complete(bar, b.x, nloc, nx); b.st[0] = nloc; b.st[1] = nx; }
    const unsigned old = xb_add(&bar[XB_XSUB(b.x)], 1u);
    const unsigned gen = old / nloc;
    if (old + 1u == (gen + 1u) * nloc) {
      __builtin_amdgcn_fence(__ATOMIC_RELEASE, "agent");
      asm volatile("s_waitcnt vmcnt(0)" ::: "memory");
      const unsigned og = xb_add(&bar[XB_TOP], 1u);
      const unsigned tg = og / nx;
      if (og + 1u == (tg + 1u) * nx) xb_add(&bar[XB_TOPGEN], 1u);
      else XB_SPIN(xb_ld(&bar[XB_TOPGEN]) == tg, bar);
      __builtin_amdgcn_fence(__ATOMIC_ACQUIRE, "agent");
      xb_add(&bar[XB_XGEN(b.x)], 1u);
      asm volatile("s_waitcnt vmcnt(0)" ::: "memory");
    } else {
      XB_SPIN(xb_ld(&bar[XB_XGEN(b.x)]) == gen, bar);
      __builtin_amdgcn_fence(__ATOMIC_ACQUIRE, "agent");
      asm volatile("s_waitcnt vmcnt(0)" ::: "memory");
    }
  }
  __syncthreads();
}

typedef const __attribute__((address_space(4))) Params* KPtr;
#if defined(__HIP_DEVICE_COMPILE__)
DI Params KP() { KPtr q = (KPtr)__builtin_amdgcn_kernarg_segment_ptr(); asm volatile("" : "+s"(q)); return *q; }
#else
DI Params KP() { return Params{}; }
#endif

DI void gsync(const Params& p, char* smem) {
  unsigned long long ba = reinterpret_cast<unsigned long long>(p.ws + WS_BAR);
  asm volatile("" : "+s"(ba));
  XcdBarrier b; b.bar = reinterpret_cast<unsigned*>(ba); b.x = xb_xcc_id();
  b.st = reinterpret_cast<volatile LAS unsigned*>((LAS unsigned char*)smem + LDS_BYTES - 16);
  xcd_barrier(b);
}

template <int LAYER>
DI void conv_layer(const Params& p, u16* WIN, u16* wout, int rank, int nranks) {
  constexpr int kind = LAYER % 3, j = LAYER / 3;
  if (kind == 0) {
    conv_job(p.gla_w_in + (size_t)j * 2048 * 6144, 6144, 6144, WIN, 0, rank, nranks);
    conv_job(p.gla_w_a1 + (size_t)j * 2048 * 16, 16, 16, WIN, 6144, rank, nranks);
    for (int id = rank * 512 + opq(threadIdx.x); id < 240 * 256; id += nranks * 512) {
      u32x4 z = {0u, 0u, 0u, 0u};
      reinterpret_cast<u32x4*>(WIN + (size_t)6160 * 2048)[id] = z;
    }
    conv_job(p.gla_w_out + (size_t)j * 2048 * 2048, 2048, 2048, wout, 0, rank, nranks);
  } else if (kind == 1) {
    conv_job(p.hgrn_w_in, 8192, 8192, WIN, 0, rank, nranks);
    conv_job(p.hgrn_w_out, 2048, 2048, wout, 0, rank, nranks);
  } else {
    conv_job(p.diff_w_in, 8192, 8192, WIN, 0, rank, nranks);
    conv_job(p.diff_w_out, 2048, 2048, wout, 0, rank, nranks);
  }
}

template <int LAYER>
DI void do_layer(char* smem, cg::grid_group& grid) {
  const Params p = KP();
  constexpr int layer = LAYER, kind = LAYER % 3, j = LAYER / 3;
  u16* WIN = reinterpret_cast<u16*>(p.ws + WS_WIN);
  u16* WOUT = reinterpret_cast<u16*>(p.ws + ((layer & 1) ? WS_WOUT1 : WS_WOUT));
  u16* WOUT_NEXT = reinterpret_cast<u16*>(p.ws + ((layer & 1) ? WS_WOUT : WS_WOUT1));
  u16* HB = reinterpret_cast<u16*>(p.ws + WS_H);
  u16* PROJ = reinterpret_cast<u16*>(p.ws + WS_PROJ);
  char* PREP_WS = p.ws + WS_PREP;
  char* PREP_OUT = reinterpret_cast<char*>(p.out + OFF_KP);
  if (layer == 0) conv_layer<0>(KP(), WIN, WOUT, blockIdx.x, gridDim.x);
  float* RS = reinterpret_cast<float*>(p.ws + WS_RS);
  u16* XW = reinterpret_cast<u16*>(p.ws + WS_XW);
  if (layer == 0) {
    norm_phase(p.x_prompt, p.x_sample, p.norm_w, HB);
    for (int i = blockIdx.x * 512 + opq(threadIdx.x); i < 4 * MROWS; i += gridDim.x * 512) RS[i] = 0.f;
    grid.sync();
    (void)xcd_barrier_post(reinterpret_cast<unsigned*>(p.ws + WS_BAR), reinterpret_cast<volatile LAS unsigned*>((LAS unsigned char*)smem + LDS_BYTES - 16));
    if (threadIdx.x == 0) {
      const unsigned x = xb_xcc_id();
      const unsigned y = xb_add(reinterpret_cast<unsigned*>(p.ws + WS_BAR) + 8 * x, 1u);
      reinterpret_cast<volatile unsigned*>(smem + LDS_BYTES - 16)[2] = (x << 16) | (y & 0xffffu);
    }
  }
  {
    pg8::EpiProj E; E.O = PROJ; E.ldc = kind == 0 ? GLA_LD : 8192; E.out = p.out; E.mode = kind == 2 ? 1 : 0;
    E.rs = layer == 0 ? nullptr : RS + (layer - 1) * MROWS;
    gemm8(smem, layer == 0 ? HB : XW, WIN, kind == 0 ? GLA_LD : 8192, E);
  }
  gsync(KP(), smem);
  if (kind == 0) {
    prep_phase<0>(KP(), layer, j, PROJ, PREP_WS, smem);
    gsync(KP(), smem);
    seq_phase<0>(KP(), j, PREP_WS, HB, smem);
  } else if (kind == 1) {
    prep_phase<1>(KP(), layer, j, PROJ, PREP_OUT, smem);
    gsync(KP(), smem);
    seq_phase<1>(KP(), j, PREP_OUT, HB, smem);
    if ((int)blockIdx.x >= 128 && gridDim.x > 128) diffprep_cache(KP(), PREP_WS, (int)blockIdx.x - 128, (int)gridDim.x - 128);
    else if (gridDim.x <= 128) diffprep_cache(KP(), PREP_WS, blockIdx.x, gridDim.x);
  } else {
    diffprep_phase(KP(), PROJ, PREP_WS, smem);
    gsync(KP(), smem);
    attn_phase(KP(), PROJ, PREP_WS, HB, smem);
  }
  gsync(KP(), smem);
  if (kind == 0) gate_phase(HB, PROJ, GLA_LD, 4096, p.gla_norm_w + j * 512, 512, 1.f);
  else if (kind == 1) gate_phase(HB, PROJ, 8192, 6144, p.hgrn_norm_w, 2048, 1.f);
  if (kind != 2) gsync(KP(), smem);
  {
    pg8::EpiRes E; E.xp = p.x_prompt; E.xs = p.x_sample; E.out = p.out; E.layer = layer;
    E.wn = p.norm_w + (layer < 3 ? (layer + 1) * DM : 0); E.xw = layer < 3 ? XW : nullptr; E.rs = RS + layer * MROWS;
    gemm8(smem, HB, WOUT, 2048, E);
    if (layer < 3) {
      const int nwg = (MROWS / 256) * (2048 / 256), G = gridDim.x, R = nwg % G;
      if ((int)blockIdx.x >= R) conv_layer<(LAYER + 1) % 4>(KP(), WIN, WOUT_NEXT, (int)blockIdx.x - R, G - R);
    }
  }
  gsync(KP(), smem);
}

__global__ void __launch_bounds__(512) mega(Params p) {
  extern __shared__ __attribute__((aligned(16))) char smem[];
  cg::grid_group grid = cg::this_grid();
  {
    unsigned* bar = reinterpret_cast<unsigned*>(p.ws + WS_BAR);
    if (blockIdx.x == 0) for (int i = threadIdx.x; i < XCD_BAR_WORDS; i += 512) bar[i] = 0u;
    if (threadIdx.x < 4) reinterpret_cast<volatile unsigned*>(smem + LDS_BYTES - 16)[threadIdx.x] = 0u;
    __syncthreads();
  }
  do_layer<0>(smem, grid);
  do_layer<1>(smem, grid);
  do_layer<2>(smem, grid);
  do_layer<3>(smem, grid);
  final_norm_phase(p.out, p.final_norm_w, reinterpret_cast<const float*>(p.ws + WS_RS) + 3 * MROWS);
}

extern "C" void kernel_launch(void* const* d_in, const int* in_sizes, int n_in, void* d_out, int out_size, void* d_ws, size_t ws_size,
                              hipStream_t stream) {
  Params p{};
  p.x_prompt = (const float*)d_in[0]; p.x_sample = (const float*)d_in[1]; p.state_gla = (const float*)d_in[2]; p.state_hgrn = (const float*)d_in[3];
  p.cache_k = (const float*)d_in[4]; p.cache_v = (const float*)d_in[5]; p.norm_w = (const float*)d_in[6]; p.final_norm_w = (const float*)d_in[7];
  p.gla_w_in = (const float*)d_in[8]; p.gla_w_a1 = (const float*)d_in[9]; p.gla_w_a2 = (const float*)d_in[10]; p.gla_b_a = (const float*)d_in[11];
  p.gla_norm_w = (const float*)d_in[12]; p.gla_w_out = (const float*)d_in[13];
  p.hgrn_w_in = (const float*)d_in[14]; p.hgrn_lb = (const float*)d_in[15]; p.hgrn_norm_w = (const float*)d_in[16]; p.hgrn_w_out = (const float*)d_in[17];
  p.diff_w_in = (const float*)d_in[18]; p.diff_lambda = (const float*)d_in[19]; p.diff_subln_w = (const float*)d_in[20]; p.diff_w_out = (const float*)d_in[21];
  p.out = (float*)d_out; p.ws = (char*)d_ws;
  static int grid_blocks = 0;
  if (!grid_blocks) {
    int dev = 0, cus = 0, per_cu = 0;
    (void)hipGetDevice(&dev);
    (void)hipFuncSetAttribute((const void*)mega, hipFuncAttributeMaxDynamicSharedMemorySize, (int)LDS_BYTES);
    (void)hipDeviceGetAttribute(&cus, hipDeviceAttributeMultiprocessorCount, dev);
    (void)hipOccupancyMaxActiveBlocksPerMultiprocessor(&per_cu, mega, 512, LDS_BYTES);
    if (per_cu < 1) per_cu = 1;
    if (per_cu > 1) per_cu = 1;
    grid_blocks = cus * per_cu;
  }
  void* args[] = {&p};
  hipError_t e = hipLaunchCooperativeKernel((void*)mega, dim3(grid_blocks), dim3(512), args, LDS_BYTES, stream);
  if (e != hipSuccess) fprintf(stderr, "cooperative launch failed: %s (grid %d)\n", hipGetErrorString(e), grid_blocks);
}
```
